# Optimizing an MI355X kernel written in HIP

```python
import jax, jax.numpy as jnp
from jax import lax
import numpy as np

D_MODEL = 1024
BATCH = 16
SEQ = 2048
DEPTH = 1

N_META = 16
CHUNK = 64
HG_HEADS = 4
HG_DK = 128
HG_DV = 128
GDN_HEADS = 4
GDN_DK = 128
GDN_DV = 128
CONV_W = 4
HG_WIDTH = HG_HEADS * HG_DK
GDN_WIDTH = GDN_HEADS * GDN_DV
D_MIX = HG_WIDTH + GDN_WIDTH
IN_COLS = 4 * HG_WIDTH + 4 * GDN_WIDTH + 2 * GDN_HEADS
EPS = 1e-6

kernel_name = "hymba_hgrn2_gated_deltanet_layer"


def rmsnorm(x, w):
    xf = x.astype(jnp.float32)
    y = xf * lax.rsqrt(jnp.mean(xf * xf, axis=-1, keepdims=True) + EPS)
    return (y * w.astype(jnp.float32)).astype(x.dtype)


def gated_rmsnorm(o, z, w):
    of = jnp.transpose(o, (0, 2, 1, 3)).astype(jnp.float32)
    y = of * lax.rsqrt(jnp.mean(of * of, axis=-1, keepdims=True) + EPS) * w.astype(jnp.float32)
    B, T = y.shape[0], y.shape[1]
    return (y.reshape(B, T, -1) * jax.nn.silu(z.astype(jnp.float32))).astype(z.dtype)


def heads(a, H):
    B, T, _ = a.shape
    return jnp.transpose(a.reshape(B, T, H, -1), (0, 2, 1, 3))


def causal_conv(x, w):
    C = x.shape[-1]
    return lax.conv_general_dilated(x, w[:, None, :].astype(x.dtype), window_strides=(1,),
                                    padding=((CONV_W - 1, 0),),
                                    dimension_numbers=('NWC', 'WIO', 'NWC'),
                                    feature_group_count=C)


def to_chunks(a, C):
    B, H, T = a.shape[:3]
    return jnp.moveaxis(a.reshape((B, H, T // C, C) + a.shape[3:]), 2, 0)


def from_chunks(o):
    nc, B, H, C, d = o.shape
    return jnp.moveaxis(o, 0, 2).reshape(B, H, nc * C, d)


def run_chunked(step, inputs, S0, C):
    xs = tuple(to_chunks(a, C) for a in inputs)
    S, o = lax.scan(step, S0, xs)
    return S, from_chunks(o)


def causal_mixer(step, inputs, S0):
    meta = tuple(a[:, :, :N_META] for a in inputs)
    real = tuple(a[:, :, N_META:] for a in inputs)
    S, o_meta = run_chunked(step, meta, S0, N_META)
    _, o_real = run_chunked(step, real, S, CHUNK)
    return jnp.concatenate([o_meta, o_real], axis=2)


def hgrn2_chunk(S, inp):
    q, k, v, logf = inp
    C = q.shape[2]
    G = jnp.cumsum(logf, axis=2)
    causal = jnp.tril(jnp.ones((C, C), dtype=bool))
    diff = G[:, :, :, None, :] - G[:, :, None, :, :]
    decay = jnp.exp(jnp.where(causal[None, None, :, :, None], diff, -jnp.inf))
    A = jnp.einsum('bhtd,bhtsd,bhsd->bhts', q, decay, k)
    o = jnp.einsum('bhts,bhsv->bhtv', A, v) + jnp.einsum('bhtd,bhdv->bhtv', q * jnp.exp(G), S)
    G_last = G[:, :, -1]
    S_new = jnp.exp(G_last)[..., None] * S + jnp.einsum(
        'bhsd,bhsv->bhdv', k * jnp.exp(G_last[:, :, None, :] - G), v)
    return S_new, o


def gdn_chunk(S, inp):
    q, k, v, g, beta = inp
    C = q.shape[2]
    dv = v.shape[-1]
    gam = jnp.cumsum(g, axis=-1)
    diff = gam[..., :, None] - gam[..., None, :]
    strict = jnp.tril(jnp.ones((C, C), dtype=bool), -1)
    incl = jnp.tril(jnp.ones((C, C), dtype=bool))
    dec_strict = jnp.exp(jnp.where(strict, diff, -jnp.inf))
    dec_incl = jnp.exp(jnp.where(incl, diff, -jnp.inf))
    A = beta[..., None] * jnp.einsum('bhtd,bhsd->bhts', k, k) * dec_strict
    lhs = jnp.eye(C, dtype=A.dtype) + A
    rhs = jnp.concatenate([beta[..., None] * v, (beta * jnp.exp(gam))[..., None] * k], axis=-1)
    sol = lax.linalg.triangular_solve(lhs, rhs, left_side=True, lower=True)
    U, W = sol[..., :dv], sol[..., dv:]
    u = U - jnp.einsum('bhtd,bhdv->bhtv', W, S)
    qk = jnp.einsum('bhtd,bhsd->bhts', q, k) * dec_incl
    o = jnp.einsum('bhtd,bhdv->bhtv', q * jnp.exp(gam)[..., None], S) + jnp.einsum('bhts,bhsv->bhtv', qk, u)
    g_last = gam[..., -1]
    S_new = jnp.exp(g_last)[..., None, None] * S + jnp.einsum(
        'bhsd,bhsv->bhdv', k * jnp.exp(g_last[..., None] - gam)[..., None], u)
    return S_new, o


def hybrid_layer(h, norm_w, w_in, conv_w, lower_bound, hg_norm_w, gdn_A_log, gdn_dt_bias, gdn_norm_w, w_out):
    B, T, _ = h.shape
    f32 = jnp.float32
    u = rmsnorm(h, norm_w)
    proj = jnp.einsum('btd,dc->btc', u, w_in)
    cuts = np.cumsum([HG_WIDTH, HG_WIDTH, HG_WIDTH, HG_WIDTH, 3 * GDN_WIDTH, GDN_WIDTH, GDN_HEADS])
    hg_q, hg_f, hg_i, hg_z, gd_qkv, gd_z, gd_a, gd_b = jnp.split(proj, [int(c) for c in cuts], axis=-1)

    q = heads(jax.nn.silu(hg_q.astype(f32)), HG_HEADS)
    lb = lower_bound.astype(f32)
    f = lb + (1.0 - lb) * jax.nn.sigmoid(hg_f.astype(f32))
    k = heads(1.0 - f, HG_HEADS)
    logf = heads(jnp.log(f), HG_HEADS)
    v = heads(hg_i.astype(f32), HG_HEADS)
    S0 = jnp.zeros((B, HG_HEADS, HG_DK, HG_DV), f32)
    o_hg = causal_mixer(hgrn2_chunk, (q, k, v, logf), S0)
    y_hg = gated_rmsnorm(o_hg, hg_z, hg_norm_w)

    qkv = jax.nn.silu(causal_conv(gd_qkv, conv_w).astype(f32))
    gq, gk, gv = jnp.split(qkv, 3, axis=-1)
    gq = heads(gq, GDN_HEADS)
    gk = heads(gk, GDN_HEADS)
    gv = heads(gv, GDN_HEADS)
    gq = gq * lax.rsqrt(jnp.sum(gq * gq, -1, keepdims=True) + EPS) * (GDN_DK ** -0.5)
    gk = gk * lax.rsqrt(jnp.sum(gk * gk, -1, keepdims=True) + EPS)
    g = -jnp.exp(gdn_A_log.astype(f32)) * jax.nn.softplus(gd_a.astype(f32) + gdn_dt_bias.astype(f32))
    g = jnp.transpose(g, (0, 2, 1))
    beta = jnp.transpose(jax.nn.sigmoid(gd_b.astype(f32)), (0, 2, 1))
    S0g = jnp.zeros((B, GDN_HEADS, GDN_DK, GDN_DV), f32)
    o_gd = causal_mixer(gdn_chunk, (gq, gk, gv, g, beta), S0g)
    y_gd = gated_rmsnorm(o_gd, gd_z, gdn_norm_w)

    y = jnp.concatenate([y_hg, y_gd], axis=-1)
    return jnp.einsum('btc,cd->btd', y, w_out).astype(h.dtype)


def setup_inputs(seed: int = 0) -> dict:
    key = jax.random.key(seed)
    ks = jax.random.split(key, 14)
    f32 = jnp.float32
    x = jax.random.normal(ks[0], (BATCH, SEQ, D_MODEL), f32)
    meta_tokens = jax.random.normal(ks[1], (N_META, D_MODEL), f32)
    norm_w = 1.0 + 0.02 * jax.random.normal(ks[2], (DEPTH, D_MODEL), f32)
    w_in = jax.random.normal(ks[3], (DEPTH, D_MODEL, IN_COLS), f32) * D_MODEL ** -0.5
    conv_w = jax.random.normal(ks[4], (DEPTH, CONV_W, 3 * GDN_WIDTH), f32) * CONV_W ** -0.5
    hg_lb_logits = 0.5 * jax.random.normal(ks[5], (DEPTH + 1, HG_WIDTH), f32)
    hg_norm_w = 1.0 + 0.02 * jax.random.normal(ks[6], (DEPTH, HG_DV), f32)
    gdn_A_log = jnp.log(jax.random.uniform(ks[7], (DEPTH, GDN_HEADS), f32, 1.0, 16.0))
    dt = jnp.exp(jax.random.uniform(ks[8], (DEPTH, GDN_HEADS), f32, jnp.log(0.001), jnp.log(0.1)))
    gdn_dt_bias = dt + jnp.log(-jnp.expm1(-dt))
    gdn_norm_w = 1.0 + 0.02 * jax.random.normal(ks[9], (DEPTH, GDN_DV), f32)
    w_out = jax.random.normal(ks[10], (DEPTH, D_MIX, D_MODEL), f32) * D_MIX ** -0.5
    final_norm_w = 1.0 + 0.02 * jax.random.normal(ks[11], (D_MODEL,), f32)
    return {"x": x, "meta_tokens": meta_tokens, "norm_w": norm_w, "w_in": w_in, "conv_w": conv_w,
            "hg_lb_logits": hg_lb_logits, "hg_norm_w": hg_norm_w, "gdn_A_log": gdn_A_log,
            "gdn_dt_bias": gdn_dt_bias, "gdn_norm_w": gdn_norm_w, "w_out": w_out,
            "final_norm_w": final_norm_w}


def reference(x, meta_tokens, norm_w, w_in, conv_w, hg_lb_logits, hg_norm_w, gdn_A_log,
              gdn_dt_bias, gdn_norm_w, w_out, final_norm_w):
    B = x.shape[0]
    meta = jnp.broadcast_to(meta_tokens[None].astype(x.dtype), (B, N_META, D_MODEL))
    h = jnp.concatenate([meta, x], axis=1)
    lower_bounds = jnp.cumsum(jax.nn.softmax(hg_lb_logits.astype(jnp.float32), axis=0), axis=0)
    for l in range(DEPTH):
        h = h + hybrid_layer(h, norm_w[l], w_in[l], conv_w[l], lower_bounds[l], hg_norm_w[l],
                             gdn_A_log[l], gdn_dt_bias[l], gdn_norm_w[l], w_out[l])
    y = rmsnorm(h, final_norm_w)
    return y[:, N_META:]
```

```cpp
#include <hip/hip_runtime.h>
#include <cstdio>
#include <cstdint>

namespace pg8 {
#define PG8_LAS __attribute__((address_space(3)))
typedef unsigned short bf16_t;
typedef short bf16x8 __attribute__((ext_vector_type(8)));
typedef float f32x4 __attribute__((ext_vector_type(4)));
typedef unsigned u32x4 __attribute__((ext_vector_type(4)));
constexpr int BM = 256, BK = 64, HALF = 128, HTB = HALF * BK * 2, STAGE_BYTES = 8 * HTB, NXCD = 8, WGM = 8;

__host__ __device__ __forceinline__ int lds_byte(int r, int c) { const int st = (r >> 4) * 2 + (c >> 5), rr = r & 15, cc = c & 31, ob = rr * 64 + cc * 2; return st * 1024 + (ob ^ (((ob >> 9) & 1) << 5)); }
__host__ __device__ __forceinline__ void stage_rc(int b, int& R, int& C) { const int st = b / 1024, sb = b % 1024, swz = sb ^ (((sb >> 9) & 1) << 5); R = (st >> 1) * 16 + swz / 64; C = (st & 1) * 32 + (swz % 64) / 2; }
__host__ __device__ __forceinline__ int perm32(int rho) { const int n = rho >> 4, i = rho & 15; return 8 * (i >> 2) + 4 * n + (i & 3); }

struct Unit { int pm, pn; };
struct Gemm { const bf16_t* A; const bf16_t* Bt; int M, N, K, pad; };

struct StaticOrder {
    int nM, nN, nwg, G, c;
    __host__ __device__ void init(int M, int N, int G_, int c_) { nM = M / BM; nN = N / BM; nwg = nM * nN; G = G_; c = c_; }
    __host__ __device__ bool next(int i, Unit& u) const {
        const long L = (long)i * G + c; if (L >= nwg) return false;
        int wgid = (int)L; { const int q = nwg / NXCD, r = nwg % NXCD, xcd = wgid % NXCD, off = wgid / NXCD; wgid = (xcd < r ? xcd * (q + 1) : r * (q + 1) + (xcd - r) * q) + off; }
        const int nig = WGM * nN, gid = wgid / nig, fm = gid * WGM, gsz = (nM - fm) < WGM ? (nM - fm) : WGM;
        u.pm = fm + ((wgid % nig) % gsz); u.pn = (wgid % nig) / gsz; return true;
    }
    __device__ __forceinline__ void a_ready(const Unit&) const {}
    __device__ __forceinline__ void done(const Unit&) const {}
};

__device__ __forceinline__ unsigned cvt_pk_bf16(float lo, float hi) { unsigned r; asm volatile("v_cvt_pk_bf16_f32 %0, %1, %2" : "=v"(r) : "v"(lo), "v"(hi)); return r; }

struct EpiBf16 {
    static constexpr bool PERM = true, AFTER_DRAIN = false;
    bf16_t* O; int ldc, pad;
    __device__ __forceinline__ void operator()(const f32x4 (&acc)[2][2][4][2], const Unit& u, int wr, int wc, int fr, int fq) const {
        const int row0 = u.pm * BM + wr * 64 + fr; const int col0 = u.pn * BM + wc * 32 + 8 * fq;
#pragma unroll
        for (int ai = 0; ai < 2; ++ai)
#pragma unroll
            for (int m = 0; m < 4; ++m) { bf16_t* rowp = O + (size_t)(row0 + ai * HALF + m * 16) * ldc + col0;
#pragma unroll
                for (int bj = 0; bj < 2; ++bj) { const f32x4 v0 = acc[ai][bj][m][0], v1 = acc[ai][bj][m][1];
                    u32x4 w; w.x = cvt_pk_bf16(v0[0], v0[1]); w.y = cvt_pk_bf16(v0[2], v0[3]); w.z = cvt_pk_bf16(v1[0], v1[1]); w.w = cvt_pk_bf16(v1[2], v1[3]);
                    *(u32x4*)(rowp + bj * HALF) = w; } }
    }
};
struct EpiResF32 {
    static constexpr bool PERM = false, AFTER_DRAIN = false;
    const float* base; float* out; int ldc, pad;
    __device__ __forceinline__ void operator()(const f32x4 (&acc)[2][2][4][2], const Unit& u, int wr, int wc, int fr, int fq) const {
        const int row0 = u.pm * BM + wr * 64 + fr, col0 = u.pn * BM + wc * 32 + 4 * fq;
#pragma unroll
        for (int ai = 0; ai < 2; ++ai)
#pragma unroll
            for (int m = 0; m < 4; ++m) { const size_t off = (size_t)(row0 + ai * HALF + m * 16) * ldc + col0;
#pragma unroll
                for (int bj = 0; bj < 2; ++bj)
#pragma unroll
                    for (int n = 0; n < 2; ++n) { const f32x4 bs = *(const f32x4*)(base + off + bj * HALF + n * 16); *(f32x4*)(out + off + bj * HALF + n * 16) = bs + acc[ai][bj][m][n]; } }
    }
};

template <class Epi, class Sched, bool ALIGN_EPI = false, bool SP2 = false>
__device__ __forceinline__ void gemm_phase(PG8_LAS unsigned char* lds, const Gemm g, const Sched& S, const Epi& E) {
    const int tid = threadIdx.x, wid = __builtin_amdgcn_readfirstlane(tid >> 6), lane = tid & 63, wr = wid >> 2, wc = wid & 3, fr = lane & 15, fq = lane >> 4;
    const int K = g.K, nt = K / BK;
    unsigned voffA[2], voffB[2];
#pragma unroll
    for (int i = 0; i < 2; ++i) { int R, C; stage_rc(tid * 16 + i * 8192, R, C); const int Rb = Epi::PERM ? ((R & ~31) + perm32(R & 31)) : R;
        voffA[i] = (unsigned)(R * K + C) * 2u; voffB[i] = (unsigned)(Rb * K + C) * 2u; }
    const size_t kstep = (size_t)(BK * 2);
    const size_t hstep = (size_t)HALF * K * 2;
    const size_t tstep = 2 * hstep;
    const unsigned ldsw = (unsigned)wid * 1024u;
    const int aoff = lds_byte(wr * 64 + fr, fq * 8), boff = lds_byte(wc * 32 + fr, fq * 8);
#define PG8_SA(b, h) (((b) * 2 + (h)) * HTB)
#define PG8_SB(b, h) ((4 + (b) * 2 + (h)) * HTB)
#define PG8_STAGE(bufoff, gbase, voff) do { _Pragma("unroll") for (int _i = 0; _i < 2; ++_i) \
        __builtin_amdgcn_global_load_lds((const unsigned*)((const char*)(gbase) + (voff)[_i]), (PG8_LAS unsigned*)(lds + (bufoff) + ldsw + _i * 8192), 16, 0, 0); } while (0)
#define PG8_LDA(dst, b, h) do { _Pragma("unroll") for (int m = 0; m < 4; ++m) _Pragma("unroll") for (int k = 0; k < 2; ++k) dst[m][k] = *(const PG8_LAS bf16x8*)(lds + PG8_SA(b, h) + aoff + m * 2048 + k * 1024); } while (0)
#define PG8_LDB(dst, b, h) do { _Pragma("unroll") for (int n = 0; n < 2; ++n) _Pragma("unroll") for (int k = 0; k < 2; ++k) dst[n][k] = *(const PG8_LAS bf16x8*)(lds + PG8_SB(b, h) + boff + n * 2048 + k * 1024); } while (0)
#define PG8_MMA(ai, bj, At, Bt) do { __builtin_amdgcn_s_setprio(1); _Pragma("unroll") for (int m = 0; m < 4; ++m) _Pragma("unroll") for (int n = 0; n < 2; ++n) _Pragma("unroll") for (int k = 0; k < 2; ++k) \
        acc[ai][bj][m][n] = __builtin_amdgcn_mfma_f32_16x16x32_bf16(Bt[n][k], At[m][k], acc[ai][bj][m][n], 0, 0, 0); __builtin_amdgcn_s_setprio(0); } while (0)
#define PG8_WAIT_V(n) asm volatile("s_waitcnt vmcnt(" #n ")" ::: "memory")
#define PG8_WAIT_L(n) asm volatile("s_waitcnt lgkmcnt(" #n ")" ::: "memory")
#define PG8_BAR __builtin_amdgcn_s_barrier()
#define PG8_SCHED __builtin_amdgcn_sched_barrier(0)
    Unit cur, nxt; int ui = 0;
    if (!S.next(0, cur)) return;
    f32x4 acc[2][2][4][2];
#pragma unroll
    for (int a = 0; a < 2; ++a)
#pragma unroll
        for (int b = 0; b < 2; ++b)
#pragma unroll
            for (int m = 0; m < 4; ++m)
#pragma unroll
                for (int n = 0; n < 2; ++n) acc[a][b][m][n] = (f32x4){0.f, 0.f, 0.f, 0.f};
    bf16x8 At[4][2], B0[2][2], B1[2][2];
    const char* cA = (const char*)g.A + (size_t)cur.pm * tstep; const char* cB = (const char*)g.Bt + (size_t)cur.pn * tstep;
    S.a_ready(cur);
    if constexpr (SP2) {
        PG8_STAGE(PG8_SB(0, 0), cB, voffB); PG8_STAGE(PG8_SB(0, 1), cB + hstep, voffB); PG8_STAGE(PG8_SA(0, 0), cA, voffA); PG8_STAGE(PG8_SA(0, 1), cA + hstep, voffA);
        if (wr == 1) PG8_BAR;
        PG8_WAIT_V(2); PG8_BAR;
        PG8_STAGE(PG8_SB(1, 0), cB + kstep, voffB); PG8_STAGE(PG8_SA(1, 0), cA + kstep, voffA); PG8_STAGE(PG8_SB(1, 1), cB + hstep + kstep, voffB);
        PG8_WAIT_V(6); PG8_BAR;
    } else {
        PG8_STAGE(PG8_SB(0, 0), cB, voffB); PG8_STAGE(PG8_SA(0, 0), cA, voffA); PG8_STAGE(PG8_SB(0, 1), cB + hstep, voffB); PG8_STAGE(PG8_SA(0, 1), cA + hstep, voffA);
        if (wr == 1) PG8_BAR;
        PG8_WAIT_V(4); PG8_BAR;
        PG8_STAGE(PG8_SB(1, 0), cB + kstep, voffB); PG8_STAGE(PG8_SA(1, 0), cA + kstep, voffA); PG8_STAGE(PG8_SB(1, 1), cB + hstep + kstep, voffB);
        PG8_WAIT_V(6); PG8_BAR;
    }
    for (;;) {
        const bool has_next = S.next(ui + 1, nxt);
        const char* nA = has_next ? (const char*)g.A + (size_t)nxt.pm * tstep : cA; const char* nB = has_next ? (const char*)g.Bt + (size_t)nxt.pn * tstep : cB;
        for (int t = 0; t < nt; t += 2) {
            const bool last = (t == nt - 2);
            const char* a1 = cA + (size_t)(t + 1) * kstep;
            const char* a2 = last ? nA : cA + (size_t)(t + 2) * kstep; const char* b2 = last ? nB : cB + (size_t)(t + 2) * kstep;
            const char* a3 = a2 + kstep; const char* b3 = b2 + kstep;
            if (last && has_next) S.a_ready(nxt);
            if constexpr (SP2) {
            PG8_LDB(B0, 0, 0); PG8_LDB(B1, 0, 1); PG8_SCHED; PG8_LDA(At, 0, 0); PG8_STAGE(PG8_SA(1, 1), a1 + hstep, voffA);
            PG8_WAIT_V(8); PG8_WAIT_L(0); PG8_BAR; PG8_MMA(0, 0, At, B0); PG8_MMA(0, 1, At, B1); PG8_BAR; PG8_SCHED;
            PG8_LDA(At, 0, 1); PG8_STAGE(PG8_SB(0, 0), b2, voffB); PG8_STAGE(PG8_SB(0, 1), b2 + hstep, voffB); PG8_STAGE(PG8_SA(0, 0), a2, voffA);
            PG8_WAIT_V(8); PG8_WAIT_L(0); PG8_BAR; PG8_MMA(1, 0, At, B0); PG8_MMA(1, 1, At, B1); PG8_BAR; PG8_SCHED;
            PG8_LDB(B0, 1, 0); PG8_LDB(B1, 1, 1); PG8_SCHED; PG8_LDA(At, 1, 0); PG8_STAGE(PG8_SA(0, 1), a2 + hstep, voffA);
            PG8_WAIT_V(8); PG8_WAIT_L(0); PG8_BAR; PG8_MMA(0, 0, At, B0); PG8_MMA(0, 1, At, B1); PG8_BAR; PG8_SCHED;
            PG8_LDA(At, 1, 1); PG8_STAGE(PG8_SB(1, 0), b3, voffB); PG8_STAGE(PG8_SB(1, 1), b3 + hstep, voffB); PG8_STAGE(PG8_SA(1, 0), a3, voffA);
            PG8_WAIT_V(8); PG8_WAIT_L(0); PG8_BAR; PG8_MMA(1, 0, At, B0); PG8_MMA(1, 1, At, B1); PG8_BAR; PG8_SCHED;
            } else {
            PG8_LDB(B0, 0, 0); PG8_SCHED; PG8_LDA(At, 0, 0); PG8_STAGE(PG8_SA(1, 1), a1 + hstep, voffA);
            PG8_WAIT_L(8); PG8_BAR; PG8_WAIT_L(0); PG8_MMA(0, 0, At, B0); PG8_BAR; PG8_SCHED;
            PG8_LDB(B1, 0, 1); PG8_STAGE(PG8_SB(0, 0), b2, voffB);
            PG8_BAR; PG8_WAIT_L(0); PG8_MMA(0, 1, At, B1); PG8_BAR;
            PG8_LDA(At, 0, 1); PG8_STAGE(PG8_SA(0, 0), a2, voffA);
            PG8_BAR; PG8_WAIT_L(0); PG8_MMA(1, 0, At, B0); PG8_BAR; PG8_SCHED;
            PG8_STAGE(PG8_SB(0, 1), b2 + hstep, voffB);
            PG8_WAIT_V(6); PG8_BAR; PG8_MMA(1, 1, At, B1); PG8_BAR;
            PG8_LDB(B0, 1, 0); PG8_SCHED; PG8_LDA(At, 1, 0); PG8_STAGE(PG8_SA(0, 1), a2 + hstep, voffA);
            PG8_WAIT_L(8); PG8_BAR; PG8_WAIT_L(0); PG8_MMA(0, 0, At, B0); PG8_BAR; PG8_SCHED;
            PG8_LDB(B1, 1, 1); PG8_STAGE(PG8_SB(1, 0), b3, voffB);
            PG8_BAR; PG8_WAIT_L(0); PG8_MMA(0, 1, At, B1); PG8_BAR;
            PG8_LDA(At, 1, 1); PG8_STAGE(PG8_SA(1, 0), a3, voffA);
            PG8_BAR; PG8_WAIT_L(0); PG8_MMA(1, 0, At, B0); PG8_BAR; PG8_SCHED;
            PG8_STAGE(PG8_SB(1, 1), b3 + hstep, voffB);
            PG8_WAIT_V(6); PG8_BAR; PG8_MMA(1, 1, At, B1); PG8_BAR;
            }
        }
        if constexpr (ALIGN_EPI) { if (wr == 0) PG8_BAR; }
        if constexpr (!Epi::AFTER_DRAIN) { E(acc, cur, wr, wc, fr, fq); S.done(cur); }
        if (!has_next) break;
#pragma unroll
        for (int a = 0; a < 2; ++a)
#pragma unroll
            for (int b = 0; b < 2; ++b)
#pragma unroll
                for (int m = 0; m < 4; ++m)
#pragma unroll
                    for (int n = 0; n < 2; ++n) acc[a][b][m][n] = (f32x4){0.f, 0.f, 0.f, 0.f};
        cur = nxt; cA = nA; cB = nB; ++ui;
        if constexpr (ALIGN_EPI) { if (wr == 1) PG8_BAR; }
    }
    PG8_WAIT_V(0);
    if constexpr (!ALIGN_EPI) { if (wr == 0) PG8_BAR; }
    PG8_BAR;
#undef PG8_SA
#undef PG8_SB
#undef PG8_STAGE
#undef PG8_LDA
#undef PG8_LDB
#undef PG8_MMA
#undef PG8_WAIT_V
#undef PG8_WAIT_L
#undef PG8_BAR
#undef PG8_SCHED
}
}

typedef unsigned short bf16;
constexpr int D = 1024, BATCH = 16, SEQ = 2048, NMETA = 16, TT = SEQ + NMETA;
constexpr int MROWS = BATCH * TT;
constexpr int MREAL = BATCH * SEQ;
constexpr int INCOLS = 4104, NPAD = 4352;
constexpr int C_HQ = 0, C_HF = 512, C_HI = 1024, C_HZ = 1536, C_GQKV = 2048, C_GZ = 3584, C_GA = 4096, C_GB = 4100;
constexpr float EPS = 1e-6f;

constexpr size_t MiB = 1u << 20;
constexpr size_t WS_WIN = 2 * MiB, WS_WOUT = 12 * MiB, WS_U = 16 * MiB, WS_PROJ = 96 * MiB, WS_Y = 384 * MiB, WS_END = 448 * MiB;

__device__ __forceinline__ unsigned f2bf(float f) { unsigned u = __builtin_bit_cast(unsigned, f); return (u + 0x7fffu + ((u >> 16) & 1u)) >> 16; }
__device__ __forceinline__ float bf2f(bf16 h) { return __builtin_bit_cast(float, (unsigned)h << 16); }
__device__ __forceinline__ float wave_sum(float v) {
#pragma unroll
    for (int o = 1; o < 64; o <<= 1) v += __shfl_xor(v, o);
    return v;
}
__device__ __forceinline__ float sigmoidf_(float x) { return 1.f / (1.f + __expf(-x)); }
__device__ __forceinline__ float siluf_(float x) { return x / (1.f + __expf(-x)); }

__global__ void __launch_bounds__(256) k_norm_in(const float* x, const float* meta, const float* norm_w, bf16* U) {
    const int lane = threadIdx.x & 63; const int gw = blockIdx.x * 4 + (threadIdx.x >> 6), NGW = gridDim.x * 4;
    for (int r = gw; r < MROWS; r += NGW) {
        const int b = r / TT, t = r % TT;
        const float* src = (t < NMETA) ? meta + (size_t)t * D : x + ((size_t)b * SEQ + (t - NMETA)) * D;
        float4 v[4]; float s = 0.f;
#pragma unroll
        for (int j = 0; j < 4; ++j) { v[j] = ((const float4*)src)[lane + 64 * j]; s += v[j].x * v[j].x + v[j].y * v[j].y + v[j].z * v[j].z + v[j].w * v[j].w; }
        const float rstd = rsqrtf(wave_sum(s) * (1.f / D) + EPS);
#pragma unroll
        for (int j = 0; j < 4; ++j) { const float4 w = ((const float4*)norm_w)[lane + 64 * j];
            uint2 o; o.x = f2bf(v[j].x * rstd * w.x) | (f2bf(v[j].y * rstd * w.y) << 16); o.y = f2bf(v[j].z * rstd * w.z) | (f2bf(v[j].w * rstd * w.w) << 16);
            ((uint2*)(U + (size_t)r * D))[lane + 64 * j] = o; }
    }
}
__global__ void __launch_bounds__(256) k_transpose_w(const float* W, int K, int N, int Npad, bf16* WT) {
    __shared__ float tile[32][33];
    const int nb = blockIdx.x, kb = blockIdx.y; const int tx = threadIdx.x & 31, ty = threadIdx.x >> 5;
    for (int i = ty; i < 32; i += 8) { const int k = kb * 32 + i, n = nb * 32 + tx; tile[i][tx] = (n < N) ? W[(size_t)k * N + n] : 0.f; }
    __syncthreads();
    for (int i = ty; i < 32; i += 8) { const int n = nb * 32 + i, k = kb * 32 + tx; if (n < Npad) WT[(size_t)n * K + k] = (bf16)f2bf(tile[tx][i]); }
}
template <class Epi>
__global__ void __launch_bounds__(512, 2) k_gemm(pg8::Gemm g, Epi E) {
    extern __shared__ __attribute__((aligned(16))) unsigned char lds[];
    pg8::StaticOrder S; S.init(g.M, g.N, gridDim.x, blockIdx.x);
    pg8::gemm_phase<Epi, pg8::StaticOrder, true, true>((PG8_LAS unsigned char*)lds, g, S, E);
}

__global__ void __launch_bounds__(256) k_hgrn2(const bf16* proj, const float* lb_logits, const float* hg_norm_w, bf16* Y) {
    __shared__ __attribute__((aligned(16))) float sq[16][128], sf[16][128], sv[16][128], sz[16][128], so[16][2][128];
    const int b = blockIdx.x >> 2, h = blockIdx.x & 3, tid = threadIdx.x, v = tid & 127, half = tid >> 7, lane = tid & 63, wave = tid >> 6;
    float S[64];
#pragma unroll
    for (int i = 0; i < 64; ++i) S[i] = 0.f;
    for (int t0 = 0; t0 < TT; t0 += 16) {
        for (int e = tid; e < 16 * 128; e += 256) { const int tt = e >> 7, d = e & 127; const bf16* pr = proj + (size_t)(b * TT + t0 + tt) * NPAD + h * 128 + d;
            const float l0 = lb_logits[h * 128 + d], l1 = lb_logits[512 + h * 128 + d]; const float lb = 1.f / (1.f + __expf(l1 - l0));
            sq[tt][d] = siluf_(bf2f(pr[C_HQ])); sf[tt][d] = lb + (1.f - lb) * sigmoidf_(bf2f(pr[C_HF])); sv[tt][d] = bf2f(pr[C_HI]); sz[tt][d] = siluf_(bf2f(pr[C_HZ])); }
        __syncthreads();
        for (int tt = 0; tt < 16; ++tt) {
            const float vv = sv[tt][v]; float acc = 0.f;
#pragma unroll
            for (int i = 0; i < 64; i += 4) { const float4 f4 = *(const float4*)&sf[tt][half * 64 + i]; const float4 q4 = *(const float4*)&sq[tt][half * 64 + i];
                S[i] = f4.x * S[i] + (1.f - f4.x) * vv; acc += S[i] * q4.x;
                S[i + 1] = f4.y * S[i + 1] + (1.f - f4.y) * vv; acc += S[i + 1] * q4.y;
                S[i + 2] = f4.z * S[i + 2] + (1.f - f4.z) * vv; acc += S[i + 2] * q4.z;
                S[i + 3] = f4.w * S[i + 3] + (1.f - f4.w) * vv; acc += S[i + 3] * q4.w; }
            so[tt][half][v] = acc;
        }
        __syncthreads();
        if (t0 >= NMETA) {
            for (int tt = wave * 4; tt < wave * 4 + 4; ++tt) {
                const float o0 = so[tt][0][lane] + so[tt][1][lane], o1 = so[tt][0][lane + 64] + so[tt][1][lane + 64];
                const float rstd = rsqrtf(wave_sum(o0 * o0 + o1 * o1) * (1.f / 128.f) + EPS);
                bf16* yr = Y + (size_t)(b * SEQ + t0 - NMETA + tt) * 1024 + h * 128;
                yr[lane] = (bf16)f2bf(o0 * rstd * hg_norm_w[lane] * sz[tt][lane]); yr[lane + 64] = (bf16)f2bf(o1 * rstd * hg_norm_w[lane + 64] * sz[tt][lane + 64]);
            }
        }
        __syncthreads();
    }
}
__global__ void __launch_bounds__(256) k_gdn(const bf16* proj, const float* conv_w, const float* A_log, const float* dt_bias, const float* gdn_norm_w, bf16* Y) {
    __shared__ __attribute__((aligned(16))) float sq[16][128], sk[16][128], sv[16][128], sz[16][128], so[16][2][128], red[2][2][128], sg[16], sb[16];
    const int b = blockIdx.x >> 2, h = blockIdx.x & 3, tid = threadIdx.x, v = tid & 127, half = tid >> 7, lane = tid & 63, wave = tid >> 6;
    float S[64];
#pragma unroll
    for (int i = 0; i < 64; ++i) S[i] = 0.f;
    const float Aneg = -__expf(A_log[h]), dtb = dt_bias[h];
    for (int t0 = 0; t0 < TT; t0 += 16) {
        for (int e = tid; e < 16 * 384; e += 256) { const int tt = e / 384, c3 = e % 384, grp = c3 >> 7, d = c3 & 127; const int ch = grp * 512 + h * 128 + d; const int t = t0 + tt;
            float a = 0.f;
#pragma unroll
            for (int j = 0; j < 4; ++j) { const int ts = t - 3 + j; if (ts >= 0) a += conv_w[j * 1536 + ch] * bf2f(proj[(size_t)(b * TT + ts) * NPAD + C_GQKV + ch]); }
            a = siluf_(a);
            if (grp == 0) sq[tt][d] = a; else if (grp == 1) sk[tt][d] = a; else sv[tt][d] = a; }
        for (int e = tid; e < 16 * 128; e += 256) { const int tt = e >> 7, d = e & 127; sz[tt][d] = siluf_(bf2f(proj[(size_t)(b * TT + t0 + tt) * NPAD + C_GZ + h * 128 + d])); }
        if (tid < 16) { const bf16* pr = proj + (size_t)(b * TT + t0 + tid) * NPAD; const float xa = bf2f(pr[C_GA + h]) + dtb; const float sp = (xa > 20.f) ? xa : log1pf(__expf(xa));
            sg[tid] = __expf(Aneg * sp); sb[tid] = sigmoidf_(bf2f(pr[C_GB + h])); }
        __syncthreads();
        for (int tt = wave * 4; tt < wave * 4 + 4; ++tt) {
            const float q0 = sq[tt][lane], q1 = sq[tt][lane + 64], k0 = sk[tt][lane], k1 = sk[tt][lane + 64];
            const float qs = rsqrtf(wave_sum(q0 * q0 + q1 * q1) + EPS) * 0.08838834764831845f, ks = rsqrtf(wave_sum(k0 * k0 + k1 * k1) + EPS);
            sq[tt][lane] = q0 * qs; sq[tt][lane + 64] = q1 * qs; sk[tt][lane] = k0 * ks; sk[tt][lane + 64] = k1 * ks;
        }
        __syncthreads();
        for (int tt = 0; tt < 16; ++tt) {
            const float a = sg[tt], bt = sb[tt]; float part = 0.f;
#pragma unroll
            for (int i = 0; i < 64; i += 4) { const float4 k4 = *(const float4*)&sk[tt][half * 64 + i]; part += k4.x * S[i] + k4.y * S[i + 1] + k4.z * S[i + 2] + k4.w * S[i + 3]; }
            red[tt & 1][half][v] = part;
            __syncthreads();
            const float kS = red[tt & 1][0][v] + red[tt & 1][1][v];
            const float u = bt * (sv[tt][v] - a * kS); float acc = 0.f;
#pragma unroll
            for (int i = 0; i < 64; i += 4) { const float4 k4 = *(const float4*)&sk[tt][half * 64 + i]; const float4 q4 = *(const float4*)&sq[tt][half * 64 + i];
                S[i] = a * S[i] + k4.x * u; acc += S[i] * q4.x;
                S[i + 1] = a * S[i + 1] + k4.y * u; acc += S[i + 1] * q4.y;
                S[i + 2] = a * S[i + 2] + k4.z * u; acc += S[i + 2] * q4.z;
                S[i + 3] = a * S[i + 3] + k4.w * u; acc += S[i + 3] * q4.w; }
            so[tt][half][v] = acc;
        }
        __syncthreads();
        if (t0 >= NMETA) {
            for (int tt = wave * 4; tt < wave * 4 + 4; ++tt) {
                const float o0 = so[tt][0][lane] + so[tt][1][lane], o1 = so[tt][0][lane + 64] + so[tt][1][lane + 64];
                const float rstd = rsqrtf(wave_sum(o0 * o0 + o1 * o1) * (1.f / 128.f) + EPS);
                bf16* yr = Y + (size_t)(b * SEQ + t0 - NMETA + tt) * 1024 + 512 + h * 128;
                yr[lane] = (bf16)f2bf(o0 * rstd * gdn_norm_w[lane] * sz[tt][lane]); yr[lane + 64] = (bf16)f2bf(o1 * rstd * gdn_norm_w[lane + 64] * sz[tt][lane + 64]);
            }
        }
        __syncthreads();
    }
}
__global__ void __launch_bounds__(256) k_norm_out(float* out, const float* w) {
    const int lane = threadIdx.x & 63; const int gw = blockIdx.x * 4 + (threadIdx.x >> 6), NGW = gridDim.x * 4;
    for (int r = gw; r < MREAL; r += NGW) {
        float4* p = (float4*)(out + (size_t)r * D); float4 v[4]; float s = 0.f;
#pragma unroll
        for (int j = 0; j < 4; ++j) { v[j] = p[lane + 64 * j]; s += v[j].x * v[j].x + v[j].y * v[j].y + v[j].z * v[j].z + v[j].w * v[j].w; }
        const float rstd = rsqrtf(wave_sum(s) * (1.f / D) + EPS);
#pragma unroll
        for (int j = 0; j < 4; ++j) { const float4 ww = ((const float4*)w)[lane + 64 * j]; float4 o; o.x = v[j].x * rstd * ww.x; o.y = v[j].y * rstd * ww.y; o.z = v[j].z * rstd * ww.z; o.w = v[j].w * rstd * ww.w; p[lane + 64 * j] = o; }
    }
}

extern "C" void kernel_launch(void* const* d_in, const int* in_sizes, int n_in, void* d_out, int out_size, void* d_ws, size_t ws_size, hipStream_t stream) {
    static int ok = 0;
    if (ok == 0) {
        if (n_in != 12 || in_sizes[0] != MREAL * D || out_size != MREAL * D || ws_size < WS_END) { fprintf(stderr, "kernel_launch: unexpected shapes n_in %d in0 %d out %d ws %zu\n", n_in, n_in > 0 ? in_sizes[0] : -1, out_size, ws_size); ok = -1; return; }
        (void)hipFuncSetAttribute((const void*)k_gemm<pg8::EpiBf16>, hipFuncAttributeMaxDynamicSharedMemorySize, pg8::STAGE_BYTES);
        (void)hipFuncSetAttribute((const void*)k_gemm<pg8::EpiResF32>, hipFuncAttributeMaxDynamicSharedMemorySize, pg8::STAGE_BYTES);
        ok = 1;
    }
    if (ok < 0) return;
    const float* x = (const float*)d_in[0]; const float* meta = (const float*)d_in[1]; const float* norm_w = (const float*)d_in[2]; const float* w_in = (const float*)d_in[3];
    const float* conv_w = (const float*)d_in[4]; const float* lb_logits = (const float*)d_in[5]; const float* hg_norm_w = (const float*)d_in[6]; const float* A_log = (const float*)d_in[7];
    const float* dt_bias = (const float*)d_in[8]; const float* gdn_norm_w = (const float*)d_in[9]; const float* w_out = (const float*)d_in[10]; const float* final_w = (const float*)d_in[11];
    unsigned char* ws = (unsigned char*)d_ws; float* out = (float*)d_out;
    bf16* Win_t = (bf16*)(ws + WS_WIN); bf16* Wout_t = (bf16*)(ws + WS_WOUT); bf16* U = (bf16*)(ws + WS_U); bf16* P = (bf16*)(ws + WS_PROJ); bf16* Y = (bf16*)(ws + WS_Y);
    k_norm_in<<<2048, 256, 0, stream>>>(x, meta, norm_w, U);
    k_transpose_w<<<dim3(NPAD / 32, D / 32), 256, 0, stream>>>(w_in, D, INCOLS, NPAD, Win_t);
    k_transpose_w<<<dim3(D / 32, D / 32), 256, 0, stream>>>(w_out, D, D, D, Wout_t);
    { pg8::Gemm g{U, Win_t, MROWS, NPAD, D}; pg8::EpiBf16 E{P, NPAD}; k_gemm<pg8::EpiBf16><<<256, 512, pg8::STAGE_BYTES, stream>>>(g, E); }
    k_hgrn2<<<64, 256, 0, stream>>>(P, lb_logits, hg_norm_w, Y);
    k_gdn<<<64, 256, 0, stream>>>(P, conv_w, A_log, dt_bias, gdn_norm_w, Y);
    { pg8::Gemm g{Y, Wout_t, MREAL, D, D}; pg8::EpiResF32 E{x, out, D}; k_gemm<pg8::EpiResF32><<<256, 512, pg8::STAGE_BYTES, stream>>>(g, E); }
    k_norm_out<<<2048, 256, 0, stream>>>(out, final_w);
}
```

```cpp
#include <hip/hip_runtime.h>
#include <cstdio>
#include <cstdint>

namespace pg8 {
#define PG8_LAS __attribute__((address_space(3)))
typedef unsigned short bf16_t;
typedef short bf16x8 __attribute__((ext_vector_type(8)));
typedef float f32x4 __attribute__((ext_vector_type(4)));
typedef unsigned u32x4 __attribute__((ext_vector_type(4)));
constexpr int BM = 256, BK = 64, HALF = 128, HTB = HALF * BK * 2, STAGE_BYTES = 8 * HTB, NXCD = 8, WGM = 8;

__host__ __device__ __forceinline__ int lds_byte(int r, int c) { const int st = (r >> 4) * 2 + (c >> 5), rr = r & 15, cc = c & 31, ob = rr * 64 + cc * 2; return st * 1024 + (ob ^ (((ob >> 9) & 1) << 5)); }
__host__ __device__ __forceinline__ void stage_rc(int b, int& R, int& C) { const int st = b / 1024, sb = b % 1024, swz = sb ^ (((sb >> 9) & 1) << 5); R = (st >> 1) * 16 + swz / 64; C = (st & 1) * 32 + (swz % 64) / 2; }
__host__ __device__ __forceinline__ int perm32(int rho) { const int n = rho >> 4, i = rho & 15; return 8 * (i >> 2) + 4 * n + (i & 3); }

struct Unit { int pm, pn; };
struct Gemm { const bf16_t* A; const bf16_t* Bt; int M, N, K, pad; };

struct StaticOrder {
    int nM, nN, nwg, G, c;
    __host__ __device__ void init(int M, int N, int G_, int c_) { nM = M / BM; nN = N / BM; nwg = nM * nN; G = G_; c = c_; }
    __host__ __device__ bool next(int i, Unit& u) const {
        const long L = (long)i * G + c; if (L >= nwg) return false;
        int wgid = (int)L; { const int q = nwg / NXCD, r = nwg % NXCD, xcd = wgid % NXCD, off = wgid / NXCD; wgid = (xcd < r ? xcd * (q + 1) : r * (q + 1) + (xcd - r) * q) + off; }
        const int nig = WGM * nN, gid = wgid / nig, fm = gid * WGM, gsz = (nM - fm) < WGM ? (nM - fm) : WGM;
        u.pm = fm + ((wgid % nig) % gsz); u.pn = (wgid % nig) / gsz; return true;
    }
    __device__ __forceinline__ void a_ready(const Unit&) const {}
    __device__ __forceinline__ void done(const Unit&) const {}
};

__device__ __forceinline__ unsigned cvt_pk_bf16(float lo, float hi) { unsigned r; asm volatile("v_cvt_pk_bf16_f32 %0, %1, %2" : "=v"(r) : "v"(lo), "v"(hi)); return r; }

struct EpiBf16 {
    static constexpr bool PERM = true, AFTER_DRAIN = false;
    bf16_t* O; int ldc, pad;
    __device__ __forceinline__ void operator()(const f32x4 (&acc)[2][2][4][2], const Unit& u, int wr, int wc, int fr, int fq) const {
        const int row0 = u.pm * BM + wr * 64 + fr; const int col0 = u.pn * BM + wc * 32 + 8 * fq;
#pragma unroll
        for (int ai = 0; ai < 2; ++ai)
#pragma unroll
            for (int m = 0; m < 4; ++m) { bf16_t* rowp = O + (size_t)(row0 + ai * HALF + m * 16) * ldc + col0;
#pragma unroll
                for (int bj = 0; bj < 2; ++bj) { const f32x4 v0 = acc[ai][bj][m][0], v1 = acc[ai][bj][m][1];
                    u32x4 w; w.x = cvt_pk_bf16(v0[0], v0[1]); w.y = cvt_pk_bf16(v0[2], v0[3]); w.z = cvt_pk_bf16(v1[0], v1[1]); w.w = cvt_pk_bf16(v1[2], v1[3]);
                    *(u32x4*)(rowp + bj * HALF) = w; } }
    }
};
struct EpiResF32 {
    static constexpr bool PERM = false, AFTER_DRAIN = false;
    const float* base; float* out; int ldc, pad;
    __device__ __forceinline__ void operator()(const f32x4 (&acc)[2][2][4][2], const Unit& u, int wr, int wc, int fr, int fq) const {
        const int row0 = u.pm * BM + wr * 64 + fr, col0 = u.pn * BM + wc * 32 + 4 * fq;
#pragma unroll
        for (int ai = 0; ai < 2; ++ai)
#pragma unroll
            for (int m = 0; m < 4; ++m) { const size_t off = (size_t)(row0 + ai * HALF + m * 16) * ldc + col0;
#pragma unroll
                for (int bj = 0; bj < 2; ++bj)
#pragma unroll
                    for (int n = 0; n < 2; ++n) { const f32x4 bs = *(const f32x4*)(base + off + bj * HALF + n * 16); *(f32x4*)(out + off + bj * HALF + n * 16) = bs + acc[ai][bj][m][n]; } }
    }
};

template <class Epi, class Sched, bool ALIGN_EPI = false, bool SP2 = false>
__device__ __forceinline__ void gemm_phase(PG8_LAS unsigned char* lds, const Gemm g, const Sched& S, const Epi& E) {
    const int tid = threadIdx.x, wid = __builtin_amdgcn_readfirstlane(tid >> 6), lane = tid & 63, wr = wid >> 2, wc = wid & 3, fr = lane & 15, fq = lane >> 4;
    const int K = g.K, nt = K / BK;
    unsigned voffA[2], voffB[2];
#pragma unroll
    for (int i = 0; i < 2; ++i) { int R, C; stage_rc(tid * 16 + i * 8192, R, C); const int Rb = Epi::PERM ? ((R & ~31) + perm32(R & 31)) : R;
        voffA[i] = (unsigned)(R * K + C) * 2u; voffB[i] = (unsigned)(Rb * K + C) * 2u; }
    const size_t kstep = (size_t)(BK * 2);
    const size_t hstep = (size_t)HALF * K * 2;
    const size_t tstep = 2 * hstep;
    const unsigned ldsw = (unsigned)wid * 1024u;
    const int aoff = lds_byte(wr * 64 + fr, fq * 8), boff = lds_byte(wc * 32 + fr, fq * 8);
#define PG8_SA(b, h) (((b) * 2 + (h)) * HTB)
#define PG8_SB(b, h) ((4 + (b) * 2 + (h)) * HTB)
#define PG8_STAGE(bufoff, gbase, voff) do { _Pragma("unroll") for (int _i = 0; _i < 2; ++_i) \
        __builtin_amdgcn_global_load_lds((const unsigned*)((const char*)(gbase) + (voff)[_i]), (PG8_LAS unsigned*)(lds + (bufoff) + ldsw + _i * 8192), 16, 0, 0); } while (0)
#define PG8_LDA(dst, b, h) do { _Pragma("unroll") for (int m = 0; m < 4; ++m) _Pragma("unroll") for (int k = 0; k < 2; ++k) dst[m][k] = *(const PG8_LAS bf16x8*)(lds + PG8_SA(b, h) + aoff + m * 2048 + k * 1024); } while (0)
#define PG8_LDB(dst, b, h) do { _Pragma("unroll") for (int n = 0; n < 2; ++n) _Pragma("unroll") for (int k = 0; k < 2; ++k) dst[n][k] = *(const PG8_LAS bf16x8*)(lds + PG8_SB(b, h) + boff + n * 2048 + k * 1024); } while (0)
#define PG8_MMA(ai, bj, At, Bt) do { __builtin_amdgcn_s_setprio(1); _Pragma("unroll") for (int m = 0; m < 4; ++m) _Pragma("unroll") for (int n = 0; n < 2; ++n) _Pragma("unroll") for (int k = 0; k < 2; ++k) \
        acc[ai][bj][m][n] = __builtin_amdgcn_mfma_f32_16x16x32_bf16(Bt[n][k], At[m][k], acc[ai][bj][m][n], 0, 0, 0); __builtin_amdgcn_s_setprio(0); } while (0)
#define PG8_WAIT_V(n) asm volatile("s_waitcnt vmcnt(" #n ")" ::: "memory")
#define PG8_WAIT_L(n) asm volatile("s_waitcnt lgkmcnt(" #n ")" ::: "memory")
#define PG8_BAR __builtin_amdgcn_s_barrier()
#define PG8_SCHED __builtin_amdgcn_sched_barrier(0)
    Unit cur, nxt; int ui = 0;
    if (!S.next(0, cur)) return;
    f32x4 acc[2][2][4][2];
#pragma unroll
    for (int a = 0; a < 2; ++a)
#pragma unroll
        for (int b = 0; b < 2; ++b)
#pragma unroll
            for (int m = 0; m < 4; ++m)
#pragma unroll
                for (int n = 0; n < 2; ++n) acc[a][b][m][n] = (f32x4){0.f, 0.f, 0.f, 0.f};
    bf16x8 At[4][2], B0[2][2], B1[2][2];
    const char* cA = (const char*)g.A + (size_t)cur.pm * tstep; const char* cB = (const char*)g.Bt + (size_t)cur.pn * tstep;
    S.a_ready(cur);
    if constexpr (SP2) {
        PG8_STAGE(PG8_SB(0, 0), cB, voffB); PG8_STAGE(PG8_SB(0, 1), cB + hstep, voffB); PG8_STAGE(PG8_SA(0, 0), cA, voffA); PG8_STAGE(PG8_SA(0, 1), cA + hstep, voffA);
        if (wr == 1) PG8_BAR;
        PG8_WAIT_V(2); PG8_BAR;
        PG8_STAGE(PG8_SB(1, 0), cB + kstep, voffB); PG8_STAGE(PG8_SA(1, 0), cA + kstep, voffA); PG8_STAGE(PG8_SB(1, 1), cB + hstep + kstep, voffB);
        PG8_WAIT_V(6); PG8_BAR;
    } else {
        PG8_STAGE(PG8_SB(0, 0), cB, voffB); PG8_STAGE(PG8_SA(0, 0), cA, voffA); PG8_STAGE(PG8_SB(0, 1), cB + hstep, voffB); PG8_STAGE(PG8_SA(0, 1), cA + hstep, voffA);
        if (wr == 1) PG8_BAR;
        PG8_WAIT_V(4); PG8_BAR;
        PG8_STAGE(PG8_SB(1, 0), cB + kstep, voffB); PG8_STAGE(PG8_SA(1, 0), cA + kstep, voffA); PG8_STAGE(PG8_SB(1, 1), cB + hstep + kstep, voffB);
        PG8_WAIT_V(6); PG8_BAR;
    }
    for (;;) {
        const bool has_next = S.next(ui + 1, nxt);
        const char* nA = has_next ? (const char*)g.A + (size_t)nxt.pm * tstep : cA; const char* nB = has_next ? (const char*)g.Bt + (size_t)nxt.pn * tstep : cB;
        for (int t = 0; t < nt; t += 2) {
            const bool last = (t == nt - 2);
            const char* a1 = cA + (size_t)(t + 1) * kstep;
            const char* a2 = last ? nA : cA + (size_t)(t + 2) * kstep; const char* b2 = last ? nB : cB + (size_t)(t + 2) * kstep;
            const char* a3 = a2 + kstep; const char* b3 = b2 + kstep;
            if (last && has_next) S.a_ready(nxt);
            if constexpr (SP2) {
            PG8_LDB(B0, 0, 0); PG8_LDB(B1, 0, 1); PG8_SCHED; PG8_LDA(At, 0, 0); PG8_STAGE(PG8_SA(1, 1), a1 + hstep, voffA);
            PG8_WAIT_V(8); PG8_WAIT_L(0); PG8_BAR; PG8_MMA(0, 0, At, B0); PG8_MMA(0, 1, At, B1); PG8_BAR; PG8_SCHED;
            PG8_LDA(At, 0, 1); PG8_STAGE(PG8_SB(0, 0), b2, voffB); PG8_STAGE(PG8_SB(0, 1), b2 + hstep, voffB); PG8_STAGE(PG8_SA(0, 0), a2, voffA);
            PG8_WAIT_V(8); PG8_WAIT_L(0); PG8_BAR; PG8_MMA(1, 0, At, B0); PG8_MMA(1, 1, At, B1); PG8_BAR; PG8_SCHED;
            PG8_LDB(B0, 1, 0); PG8_LDB(B1, 1, 1); PG8_SCHED; PG8_LDA(At, 1, 0); PG8_STAGE(PG8_SA(0, 1), a2 + hstep, voffA);
            PG8_WAIT_V(8); PG8_WAIT_L(0); PG8_BAR; PG8_MMA(0, 0, At, B0); PG8_MMA(0, 1, At, B1); PG8_BAR; PG8_SCHED;
            PG8_LDA(At, 1, 1); PG8_STAGE(PG8_SB(1, 0), b3, voffB); PG8_STAGE(PG8_SB(1, 1), b3 + hstep, voffB); PG8_STAGE(PG8_SA(1, 0), a3, voffA);
            PG8_WAIT_V(8); PG8_WAIT_L(0); PG8_BAR; PG8_MMA(1, 0, At, B0); PG8_MMA(1, 1, At, B1); PG8_BAR; PG8_SCHED;
            } else {
            PG8_LDB(B0, 0, 0); PG8_SCHED; PG8_LDA(At, 0, 0); PG8_STAGE(PG8_SA(1, 1), a1 + hstep, voffA);
            PG8_WAIT_L(8); PG8_BAR; PG8_WAIT_L(0); PG8_MMA(0, 0, At, B0); PG8_BAR; PG8_SCHED;
            PG8_LDB(B1, 0, 1); PG8_STAGE(PG8_SB(0, 0), b2, voffB);
            PG8_BAR; PG8_WAIT_L(0); PG8_MMA(0, 1, At, B1); PG8_BAR;
            PG8_LDA(At, 0, 1); PG8_STAGE(PG8_SA(0, 0), a2, voffA);
            PG8_BAR; PG8_WAIT_L(0); PG8_MMA(1, 0, At, B0); PG8_BAR; PG8_SCHED;
            PG8_STAGE(PG8_SB(0, 1), b2 + hstep, voffB);
            PG8_WAIT_V(6); PG8_BAR; PG8_MMA(1, 1, At, B1); PG8_BAR;
            PG8_LDB(B0, 1, 0); PG8_SCHED; PG8_LDA(At, 1, 0); PG8_STAGE(PG8_SA(0, 1), a2 + hstep, voffA);
            PG8_WAIT_L(8); PG8_BAR; PG8_WAIT_L(0); PG8_MMA(0, 0, At, B0); PG8_BAR; PG8_SCHED;
            PG8_LDB(B1, 1, 1); PG8_STAGE(PG8_SB(1, 0), b3, voffB);
            PG8_BAR; PG8_WAIT_L(0); PG8_MMA(0, 1, At, B1); PG8_BAR;
            PG8_LDA(At, 1, 1); PG8_STAGE(PG8_SA(1, 0), a3, voffA);
            PG8_BAR; PG8_WAIT_L(0); PG8_MMA(1, 0, At, B0); PG8_BAR; PG8_SCHED;
            PG8_STAGE(PG8_SB(1, 1), b3 + hstep, voffB);
            PG8_WAIT_V(6); PG8_BAR; PG8_MMA(1, 1, At, B1); PG8_BAR;
            }
        }
        if constexpr (ALIGN_EPI) { if (wr == 0) PG8_BAR; }
        if constexpr (!Epi::AFTER_DRAIN) { E(acc, cur, wr, wc, fr, fq); S.done(cur); }
        if (!has_next) break;
#pragma unroll
        for (int a = 0; a < 2; ++a)
#pragma unroll
            for (int b = 0; b < 2; ++b)
#pragma unroll
                for (int m = 0; m < 4; ++m)
#pragma unroll
                    for (int n = 0; n < 2; ++n) acc[a][b][m][n] = (f32x4){0.f, 0.f, 0.f, 0.f};
        cur = nxt; cA = nA; cB = nB; ++ui;
        if constexpr (ALIGN_EPI) { if (wr == 1) PG8_BAR; }
    }
    PG8_WAIT_V(0);
    if constexpr (!ALIGN_EPI) { if (wr == 0) PG8_BAR; }
    PG8_BAR;
#undef PG8_SA
#undef PG8_SB
#undef PG8_STAGE
#undef PG8_LDA
#undef PG8_LDB
#undef PG8_MMA
#undef PG8_WAIT_V
#undef PG8_WAIT_L
#undef PG8_BAR
#undef PG8_SCHED
}
}

typedef unsigned short bf16;
constexpr int NWAVES = 8, NT = NWAVES * 64;
constexpr int D = 1024, BATCH = 16, SEQ = 2048, NMETA = 16, TT = SEQ + NMETA;
constexpr int MROWS = BATCH * TT;
constexpr int MREAL = BATCH * SEQ;
constexpr int INCOLS = 4104, NPAD = 4352;
constexpr int C_HQ = 0, C_HF = 512, C_HI = 1024, C_HZ = 1536, C_GQKV = 2048, C_GZ = 3584, C_GA = 4096, C_GB = 4100;
constexpr float EPS = 1e-6f;

constexpr size_t MiB = 1u << 20;
constexpr size_t WS_CTL = 0, CTL_ZERO_BYTES = 64 * 1024;
constexpr size_t WS_WIN = 2 * MiB, WS_WOUT = 12 * MiB, WS_U = 16 * MiB, WS_PROJ = 96 * MiB, WS_Y = 384 * MiB, WS_END = 448 * MiB;
constexpr int RING_BYTES = 131072, MISC_OFF = RING_BYTES, LDS_BYTES = 147456;

#define LAS __attribute__((address_space(3)))
__device__ __forceinline__ unsigned f2bf(float f) { unsigned u = __builtin_bit_cast(unsigned, f); return (u + 0x7fffu + ((u >> 16) & 1u)) >> 16; }
__device__ __forceinline__ float bf2f(bf16 h) { return __builtin_bit_cast(float, (unsigned)h << 16); }
__device__ __forceinline__ float wave_sum(float v) {
#pragma unroll
    for (int o = 1; o < 64; o <<= 1) v += __shfl_xor(v, o);
    return v;
}
__device__ __forceinline__ float sigmoidf_(float x) { return 1.f / (1.f + __expf(-x)); }
__device__ __forceinline__ float siluf_(float x) { return x / (1.f + __expf(-x)); }

#define XB_TMO      128
#define XB_XCNT(j)  (256  + 64 * (j))
#define XB_XSUB(j)  (1280 + 64 * (j))
#define XB_XGEN(j)  (2304 + 64 * (j))
#define XB_TOP      3328
#define XB_TOPGEN   3392
#define XCD_BAR_WORDS 3456
#define XB_SPIN_CAP (1u << 18)
__device__ __forceinline__ unsigned xb_ld(unsigned* p)              { return __hip_atomic_load(p, __ATOMIC_RELAXED, __HIP_MEMORY_SCOPE_AGENT); }
__device__ __forceinline__ unsigned xb_add(unsigned* p, unsigned v) { return __hip_atomic_fetch_add(p, v, __ATOMIC_RELAXED, __HIP_MEMORY_SCOPE_AGENT); }
__device__ __forceinline__ unsigned xb_xcc_id() { return (unsigned)__builtin_amdgcn_s_getreg((3 << 11) | 20) & 0xFu; }
#define XB_SPIN(cond, bar) do { unsigned _sp = 0; while (cond) { __builtin_amdgcn_s_sleep(1); \
    if ((++_sp & 255u) == 0u) { if (xb_ld(&(bar)[XB_TMO])) break; if (_sp > XB_SPIN_CAP) { atomicAdd(&(bar)[XB_TMO], 1u); break; } } } } while (0)
struct XcdBarrier { unsigned* bar; unsigned x; volatile LAS unsigned* st; };
__device__ __forceinline__ XcdBarrier xcd_barrier_post(unsigned* bar, volatile LAS unsigned* st) {
    XcdBarrier b; b.bar = bar; b.x = xb_xcc_id(); b.st = st;
    if (threadIdx.x == 0) (void)xb_add(&bar[XB_XCNT(b.x)], 1u);
    return b;
}
__device__ __forceinline__ void xcd_barrier_complete(unsigned* bar, unsigned x, unsigned& nloc, unsigned& nx) {
    const unsigned G = gridDim.x * gridDim.y * gridDim.z;
    unsigned sum, cnt, mine, sp = 0u;
    for (;;) {
        sum = 0u; cnt = 0u; mine = 0u;
#pragma unroll
        for (unsigned j = 0; j < 16; ++j) { const unsigned c = xb_ld(&bar[XB_XCNT(j)]); sum += c; cnt += (c > 0u) ? 1u : 0u; mine = (j == x) ? c : mine; }
        if (sum == G) break;
        __builtin_amdgcn_s_sleep(1);
        if ((++sp & 255u) == 0u) { if (xb_ld(&bar[XB_TMO])) break; if (sp > XB_SPIN_CAP) { atomicAdd(&bar[XB_TMO], 1u); break; } }
    }
    nloc = mine > 0u ? mine : 1u; nx = cnt > 0u ? cnt : 1u;
}
__device__ __forceinline__ void xcd_barrier(const XcdBarrier& b) {
    asm volatile("s_waitcnt vmcnt(0)" ::: "memory");
    __syncthreads();
    if (threadIdx.x == 0) {
        unsigned* bar = b.bar;
        __builtin_amdgcn_s_waitcnt(0);
        unsigned nloc = b.st[0], nx = b.st[1];
        if (nloc == 0u) { xcd_barrier_complete(bar, b.x, nloc, nx); b.st[0] = nloc; b.st[1] = nx; }
        const unsigned old = xb_add(&bar[XB_XSUB(b.x)], 1u);
        const unsigned gen = old / nloc;
        if (old + 1u == (gen + 1u) * nloc) {
            __builtin_amdgcn_fence(__ATOMIC_RELEASE, "agent");
            asm volatile("s_waitcnt vmcnt(0)" ::: "memory");
            const unsigned og = xb_add(&bar[XB_TOP], 1u);
            const unsigned tg = og / nx;
            if (og + 1u == (tg + 1u) * nx) xb_add(&bar[XB_TOPGEN], 1u);
            else XB_SPIN(xb_ld(&bar[XB_TOPGEN]) == tg, bar);
            __builtin_amdgcn_fence(__ATOMIC_ACQUIRE, "agent");
            xb_add(&bar[XB_XGEN(b.x)], 1u);
            asm volatile("s_waitcnt vmcnt(0)" ::: "memory");
        } else {
            XB_SPIN(xb_ld(&bar[XB_XGEN(b.x)]) == gen, bar);
            __builtin_amdgcn_fence(__ATOMIC_ACQUIRE, "agent");
            asm volatile("s_waitcnt vmcnt(0)" ::: "memory");
        }
    }
    __syncthreads();
}

__device__ __forceinline__ void p_norm_in(const float* x, const float* meta, const float* norm_w, bf16* U, int gw, int NGW, int lane) {
    for (int r = gw; r < MROWS; r += NGW) {
        const int b = r / TT, t = r % TT;
        const float* src = (t < NMETA) ? meta + (size_t)t * D : x + ((size_t)b * SEQ + (t - NMETA)) * D;
        float4 v[4]; float s = 0.f;
#pragma unroll
        for (int j = 0; j < 4; ++j) { v[j] = ((const float4*)src)[lane + 64 * j]; s += v[j].x * v[j].x + v[j].y * v[j].y + v[j].z * v[j].z + v[j].w * v[j].w; }
        const float rstd = rsqrtf(wave_sum(s) * (1.f / D) + EPS);
#pragma unroll
        for (int j = 0; j < 4; ++j) { const float4 w = ((const float4*)norm_w)[lane + 64 * j];
            uint2 o; o.x = f2bf(v[j].x * rstd * w.x) | (f2bf(v[j].y * rstd * w.y) << 16); o.y = f2bf(v[j].z * rstd * w.z) | (f2bf(v[j].w * rstd * w.w) << 16);
            ((uint2*)(U + (size_t)r * D))[lane + 64 * j] = o; }
    }
}
__device__ __forceinline__ void p_transpose_item(const float* W, int K, int N, bf16* WT, LAS float* scr, int item, int lane) {
    const int nblk = (N + 31) / 32; const int kb = item / nblk, nb = item % nblk, k0 = 64 * kb, n0 = 32 * nb;
    const int nn = n0 + (lane & 31);
#pragma unroll 8
    for (int i = 0; i < 32; ++i) { const int kk = 2 * i + (lane >> 5); scr[kk * 33 + (lane & 31)] = (nn < N) ? W[(size_t)(k0 + kk) * N + nn] : 0.f; }
    asm volatile("s_waitcnt lgkmcnt(0)" ::: "memory");
    const int c = lane & 7;
#pragma unroll
    for (int j = 0; j < 4; ++j) { const int n = (lane >> 3) + 8 * j; const LAS float* sp = scr + (8 * c) * 33 + n;
        uint4 o; o.x = f2bf(sp[0 * 33]) | (f2bf(sp[1 * 33]) << 16); o.y = f2bf(sp[2 * 33]) | (f2bf(sp[3 * 33]) << 16); o.z = f2bf(sp[4 * 33]) | (f2bf(sp[5 * 33]) << 16); o.w = f2bf(sp[6 * 33]) | (f2bf(sp[7 * 33]) << 16);
        *(uint4*)(WT + (size_t)(n0 + n) * K + k0 + 8 * c) = o; }
    asm volatile("s_waitcnt lgkmcnt(0)" ::: "memory");
}

__device__ __forceinline__ void p_hgrn2(LAS float* L, int b, int h, const bf16* proj, const float* lb_logits, const float* hg_norm_w, bf16* Y) {
    LAS float* sq = L; LAS float* sf = L + 2048; LAS float* sv = L + 4096; LAS float* sz = L + 6144; LAS float* so = L + 8192;
    const int tid = threadIdx.x, v = tid & 127, part = tid >> 7, lane = tid & 63, wave = tid >> 6;
    float S[32];
#pragma unroll
    for (int i = 0; i < 32; ++i) S[i] = 0.f;
    for (int t0 = 0; t0 < TT; t0 += 16) {
        for (int e = tid; e < 16 * 128; e += NT) { const int tt = e >> 7, d = e & 127; const bf16* pr = proj + (size_t)(b * TT + t0 + tt) * NPAD + h * 128 + d;
            const float l0 = lb_logits[h * 128 + d], l1 = lb_logits[512 + h * 128 + d]; const float lb = 1.f / (1.f + __expf(l1 - l0));
            sq[e] = siluf_(bf2f(pr[C_HQ])); sf[e] = lb + (1.f - lb) * sigmoidf_(bf2f(pr[C_HF])); sv[e] = bf2f(pr[C_HI]); sz[e] = siluf_(bf2f(pr[C_HZ])); }
        __syncthreads();
        for (int tt = 0; tt < 16; ++tt) {
            const float vv = sv[tt * 128 + v]; float acc = 0.f;
#pragma unroll
            for (int i = 0; i < 32; i += 4) { const pg8::f32x4 f4 = *(const LAS pg8::f32x4*)&sf[tt * 128 + part * 32 + i]; const pg8::f32x4 q4 = *(const LAS pg8::f32x4*)&sq[tt * 128 + part * 32 + i];
                S[i] = f4.x * S[i] + (1.f - f4.x) * vv; acc += S[i] * q4.x;
                S[i + 1] = f4.y * S[i + 1] + (1.f - f4.y) * vv; acc += S[i + 1] * q4.y;
                S[i + 2] = f4.z * S[i + 2] + (1.f - f4.z) * vv; acc += S[i + 2] * q4.z;
                S[i + 3] = f4.w * S[i + 3] + (1.f - f4.w) * vv; acc += S[i + 3] * q4.w; }
            so[(tt * 4 + part) * 128 + v] = acc;
        }
        __syncthreads();
        if (t0 >= NMETA) {
            for (int tt = wave * 2; tt < wave * 2 + 2; ++tt) {
                const float o0 = so[(tt * 4) * 128 + lane] + so[(tt * 4 + 1) * 128 + lane] + so[(tt * 4 + 2) * 128 + lane] + so[(tt * 4 + 3) * 128 + lane];
                const float o1 = so[(tt * 4) * 128 + lane + 64] + so[(tt * 4 + 1) * 128 + lane + 64] + so[(tt * 4 + 2) * 128 + lane + 64] + so[(tt * 4 + 3) * 128 + lane + 64];
                const float rstd = rsqrtf(wave_sum(o0 * o0 + o1 * o1) * (1.f / 128.f) + EPS);
                bf16* yr = Y + (size_t)(b * SEQ + t0 - NMETA + tt) * 1024 + h * 128;
                yr[lane] = (bf16)f2bf(o0 * rstd * hg_norm_w[lane] * sz[tt * 128 + lane]); yr[lane + 64] = (bf16)f2bf(o1 * rstd * hg_norm_w[lane + 64] * sz[tt * 128 + lane + 64]);
            }
        }
        __syncthreads();
    }
}
__device__ __forceinline__ void p_gdn(LAS float* L, int b, int h, const bf16* proj, const float* conv_w, const float* A_log, const float* dt_bias, const float* gdn_norm_w, bf16* Y) {
    LAS float* sq = L; LAS float* sk = L + 2048; LAS float* sv = L + 4096; LAS float* sz = L + 6144; LAS float* so = L + 8192;
    LAS float* red = L + 16384;
    LAS float* sg = L + 17408; LAS float* sb = L + 17424;
    const int tid = threadIdx.x, v = tid & 127, part = tid >> 7, lane = tid & 63, wave = tid >> 6;
    float S[32];
#pragma unroll
    for (int i = 0; i < 32; ++i) S[i] = 0.f;
    const float Aneg = -__expf(A_log[h]), dtb = dt_bias[h];
    for (int t0 = 0; t0 < TT; t0 += 16) {
        for (int e = tid; e < 16 * 384; e += NT) { const int tt = e / 384, c3 = e % 384, grp = c3 >> 7, d = c3 & 127; const int ch = grp * 512 + h * 128 + d; const int t = t0 + tt;
            float a = 0.f;
#pragma unroll
            for (int j = 0; j < 4; ++j) { const int ts = t - 3 + j; if (ts >= 0) a += conv_w[j * 1536 + ch] * bf2f(proj[(size_t)(b * TT + ts) * NPAD + C_GQKV + ch]); }
            a = siluf_(a);
            if (grp == 0) sq[tt * 128 + d] = a; else if (grp == 1) sk[tt * 128 + d] = a; else sv[tt * 128 + d] = a; }
        for (int e = tid; e < 16 * 128; e += NT) { const int tt = e >> 7, d = e & 127; sz[e] = siluf_(bf2f(proj[(size_t)(b * TT + t0 + tt) * NPAD + C_GZ + h * 128 + d])); }
        if (tid < 16) { const bf16* pr = proj + (size_t)(b * TT + t0 + tid) * NPAD; const float xa = bf2f(pr[C_GA + h]) + dtb; const float sp = (xa > 20.f) ? xa : log1pf(__expf(xa));
            sg[tid] = __expf(Aneg * sp); sb[tid] = sigmoidf_(bf2f(pr[C_GB + h])); }
        __syncthreads();
        for (int tt = wave * 2; tt < wave * 2 + 2; ++tt) {
            const float q0 = sq[tt * 128 + lane], q1 = sq[tt * 128 + lane + 64], k0 = sk[tt * 128 + lane], k1 = sk[tt * 128 + lane + 64];
            const float qs = rsqrtf(wave_sum(q0 * q0 + q1 * q1) + EPS) * 0.08838834764831845f, ks = rsqrtf(wave_sum(k0 * k0 + k1 * k1) + EPS);
            sq[tt * 128 + lane] = q0 * qs; sq[tt * 128 + lane + 64] = q1 * qs; sk[tt * 128 + lane] = k0 * ks; sk[tt * 128 + lane + 64] = k1 * ks;
        }
        __syncthreads();
        for (int tt = 0; tt < 16; ++tt) {
            const float a = sg[tt], bt = sb[tt]; float prt = 0.f;
#pragma unroll
            for (int i = 0; i < 32; i += 4) { const pg8::f32x4 k4 = *(const LAS pg8::f32x4*)&sk[tt * 128 + part * 32 + i]; prt += k4.x * S[i] + k4.y * S[i + 1] + k4.z * S[i + 2] + k4.w * S[i + 3]; }
            red[((tt & 1) * 4 + part) * 128 + v] = prt;
            __syncthreads();
            const LAS float* rr = red + (tt & 1) * 512 + v;
            const float kS = rr[0] + rr[128] + rr[256] + rr[384];
            const float u = bt * (sv[tt * 128 + v] - a * kS); float acc = 0.f;
#pragma unroll
            for (int i = 0; i < 32; i += 4) { const pg8::f32x4 k4 = *(const LAS pg8::f32x4*)&sk[tt * 128 + part * 32 + i]; const pg8::f32x4 q4 = *(const LAS pg8::f32x4*)&sq[tt * 128 + part * 32 + i];
                S[i] = a * S[i] + k4.x * u; acc += S[i] * q4.x;
                S[i + 1] = a * S[i + 1] + k4.y * u; acc += S[i + 1] * q4.y;
                S[i + 2] = a * S[i + 2] + k4.z * u; acc += S[i + 2] * q4.z;
                S[i + 3] = a * S[i + 3] + k4.w * u; acc += S[i + 3] * q4.w; }
            so[(tt * 4 + part) * 128 + v] = acc;
        }
        __syncthreads();
        if (t0 >= NMETA) {
            for (int tt = wave * 2; tt < wave * 2 + 2; ++tt) {
                const float o0 = so[(tt * 4) * 128 + lane] + so[(tt * 4 + 1) * 128 + lane] + so[(tt * 4 + 2) * 128 + lane] + so[(tt * 4 + 3) * 128 + lane];
                const float o1 = so[(tt * 4) * 128 + lane + 64] + so[(tt * 4 + 1) * 128 + lane + 64] + so[(tt * 4 + 2) * 128 + lane + 64] + so[(tt * 4 + 3) * 128 + lane + 64];
                const float rstd = rsqrtf(wave_sum(o0 * o0 + o1 * o1) * (1.f / 128.f) + EPS);
                bf16* yr = Y + (size_t)(b * SEQ + t0 - NMETA + tt) * 1024 + 512 + h * 128;
                yr[lane] = (bf16)f2bf(o0 * rstd * gdn_norm_w[lane] * sz[tt * 128 + lane]); yr[lane + 64] = (bf16)f2bf(o1 * rstd * gdn_norm_w[lane + 64] * sz[tt * 128 + lane + 64]);
            }
        }
        __syncthreads();
    }
}
__device__ __forceinline__ void p_norm_out(float* out, const float* w, int gw, int NGW, int lane) {
    for (int r = gw; r < MREAL; r += NGW) {
        float4* p = (float4*)(out + (size_t)r * D); float4 v[4]; float s = 0.f;
#pragma unroll
        for (int j = 0; j < 4; ++j) { v[j] = p[lane + 64 * j]; s += v[j].x * v[j].x + v[j].y * v[j].y + v[j].z * v[j].z + v[j].w * v[j].w; }
        const float rstd = rsqrtf(wave_sum(s) * (1.f / D) + EPS);
#pragma unroll
        for (int j = 0; j < 4; ++j) { const float4 ww = ((const float4*)w)[lane + 64 * j]; float4 o; o.x = v[j].x * rstd * ww.x; o.y = v[j].y * rstd * ww.y; o.z = v[j].z * rstd * ww.z; o.w = v[j].w * rstd * ww.w; p[lane + 64 * j] = o; }
    }
}

struct Args { const float* in[12]; float* out; unsigned char* ws; };
__global__ void __launch_bounds__(NT, 2) fwd_megakernel(Args args) {
    extern __shared__ __attribute__((aligned(16))) unsigned char lds[];
    LAS unsigned char* L = (LAS unsigned char*)lds;
    volatile LAS unsigned* MISC = (volatile LAS unsigned*)(L + MISC_OFF);
    const int tid = threadIdx.x, lane = tid & 63, wave = __builtin_amdgcn_readfirstlane(tid >> 6);
    const int G = gridDim.x; const int bx = blockIdx.x; const int vcu = (G % 8 == 0) ? (bx % 8) * (G / 8) + bx / 8 : bx;
    const float* x = args.in[0]; const float* meta = args.in[1]; const float* norm_w = args.in[2]; const float* w_in = args.in[3];
    const float* conv_w = args.in[4]; const float* lb_logits = args.in[5]; const float* hg_norm_w = args.in[6]; const float* A_log = args.in[7];
    const float* dt_bias = args.in[8]; const float* gdn_norm_w = args.in[9]; const float* w_out = args.in[10]; const float* final_w = args.in[11];
    unsigned char* ws = args.ws; float* out = args.out;
    bf16* Win_t = (bf16*)(ws + WS_WIN); bf16* Wout_t = (bf16*)(ws + WS_WOUT); bf16* U = (bf16*)(ws + WS_U); bf16* P = (bf16*)(ws + WS_PROJ); bf16* Y = (bf16*)(ws + WS_Y);
    for (int u = tid; u < (LDS_BYTES - MISC_OFF) / 4; u += NT) ((LAS unsigned*)(L + MISC_OFF))[u] = 0u;
    __syncthreads();
    XcdBarrier bar = xcd_barrier_post((unsigned*)(ws + WS_CTL), MISC + 8);
    const int gw = vcu * NWAVES + wave, NGW = G * NWAVES;

    {
        LAS float* scr = (LAS float*)(L + wave * 16384);
        constexpr int I_IN = (D / 64) * (NPAD / 32), I_OUT = (D / 64) * (D / 32);
        for (int it = gw; it < I_IN + I_OUT; it += NGW) {
            if (it < I_IN) { const int kb = it / (NPAD / 32), nb = it % (NPAD / 32);
                const int nblk = (INCOLS + 31) / 32;
                if (nb < nblk) p_transpose_item(w_in, D, INCOLS, Win_t, scr, kb * nblk + nb, lane);
                else { const int c = lane & 7;
#pragma unroll
                    for (int j = 0; j < 4; ++j) { const int n = (lane >> 3) + 8 * j; *(uint4*)(Win_t + (size_t)(nb * 32 + n) * D + kb * 64 + 8 * c) = make_uint4(0u, 0u, 0u, 0u); } }
            } else p_transpose_item(w_out, D, D, Wout_t, scr, it - I_IN, lane);
        }
        p_norm_in(x, meta, norm_w, U, gw, NGW, lane);
    }
    xcd_barrier(bar);
    { pg8::Gemm g{U, Win_t, MROWS, NPAD, D, 0}; pg8::StaticOrder S; S.init(MROWS, NPAD, G, bx); pg8::EpiBf16 E{P, NPAD, 0};
      pg8::gemm_phase<pg8::EpiBf16, pg8::StaticOrder, true, true>(L, g, S, E); }
    xcd_barrier(bar);
    for (int unit = bx; unit < 128; unit += G) {
        if (unit < 64) p_hgrn2((LAS float*)L, unit >> 2, unit & 3, P, lb_logits, hg_norm_w, Y);
        else p_gdn((LAS float*)L, (unit - 64) >> 2, unit & 3, P, conv_w, A_log, dt_bias, gdn_norm_w, Y);
    }
    xcd_barrier(bar);
    { pg8::Gemm g{Y, Wout_t, MREAL, D, D, 0}; pg8::StaticOrder S; S.init(MREAL, D, G, bx); pg8::EpiResF32 E{x, out, D, 0};
      pg8::gemm_phase<pg8::EpiResF32, pg8::StaticOrder, true, true>(L, g, S, E); }
    xcd_barrier(bar);
    p_norm_out(out, final_w, gw, NGW, lane);
}

extern "C" void kernel_launch(void* const* d_in, const int* in_sizes, int n_in, void* d_out, int out_size, void* d_ws, size_t ws_size, hipStream_t stream) {
    static int grid = 0;
    if (grid == 0) {
        if (n_in != 12 || in_sizes[0] != MREAL * D || out_size != MREAL * D || ws_size < WS_END) { fprintf(stderr, "kernel_launch: unexpected shapes n_in %d in0 %d out %d ws %zu\n", n_in, n_in > 0 ? in_sizes[0] : -1, out_size, ws_size); grid = -1; return; }
        int dev = 0, cus = 0, per_cu = 0;
        if (hipGetDevice(&dev) != hipSuccess || hipDeviceGetAttribute(&cus, hipDeviceAttributeMultiprocessorCount, dev) != hipSuccess) { grid = -1; return; }
        if (hipFuncSetAttribute((const void*)fwd_megakernel, hipFuncAttributeMaxDynamicSharedMemorySize, LDS_BYTES) != hipSuccess) { fprintf(stderr, "kernel_launch: hipFuncSetAttribute failed\n"); grid = -1; return; }
        if (hipOccupancyMaxActiveBlocksPerMultiprocessor(&per_cu, (const void*)fwd_megakernel, NT, LDS_BYTES) != hipSuccess || per_cu < 1) { fprintf(stderr, "kernel_launch: occupancy query says %d blocks/CU\n", per_cu); }
        (void)hipGetLastError();
        grid = cus;
    }
    if (grid < 0) return;
    if (hipMemsetAsync((char*)d_ws + WS_CTL, 0, CTL_ZERO_BYTES, stream) != hipSuccess) return;
    Args a{};
    for (int i = 0; i < 12; ++i) a.in[i] = (const float*)d_in[i];
    a.out = (float*)d_out; a.ws = (unsigned char*)d_ws;
    hipLaunchKernelGGL(fwd_megakernel, dim3(grid), dim3(NT), LDS_BYTES, stream, a);
}
```

```cpp
#include <hip/hip_runtime.h>
#include <cstdio>
#include <cstdint>

namespace pg8 {
#define PG8_LAS __attribute__((address_space(3)))
typedef unsigned short bf16_t;
typedef short bf16x8 __attribute__((ext_vector_type(8)));
typedef float f32x4 __attribute__((ext_vector_type(4)));
typedef unsigned u32x4 __attribute__((ext_vector_type(4)));
constexpr int BM = 256, BK = 64, HALF = 128, HTB = HALF * BK * 2, STAGE_BYTES = 8 * HTB, NXCD = 8, WGM = 8;

__host__ __device__ __forceinline__ int lds_byte(int r, int c) { const int st = (r >> 4) * 2 + (c >> 5), rr = r & 15, cc = c & 31, ob = rr * 64 + cc * 2; return st * 1024 + (ob ^ (((ob >> 9) & 1) << 5)); }
__host__ __device__ __forceinline__ void stage_rc(int b, int& R, int& C) { const int st = b / 1024, sb = b % 1024, swz = sb ^ (((sb >> 9) & 1) << 5); R = (st >> 1) * 16 + swz / 64; C = (st & 1) * 32 + (swz % 64) / 2; }
__host__ __device__ __forceinline__ int perm32(int rho) { const int n = rho >> 4, i = rho & 15; return 8 * (i >> 2) + 4 * n + (i & 3); }

struct Unit { int pm, pn; };
struct Gemm { const bf16_t* A; const bf16_t* Bt; int M, N, K, pad; };

struct StaticOrder {
    int nM, nN, nwg, G, c;
    __host__ __device__ void init(int M, int N, int G_, int c_) { nM = M / BM; nN = N / BM; nwg = nM * nN; G = G_; c = c_; }
    __host__ __device__ bool next(int i, Unit& u) const {
        const long L = (long)i * G + c; if (L >= nwg) return false;
        int wgid = (int)L; { const int q = nwg / NXCD, r = nwg % NXCD, xcd = wgid % NXCD, off = wgid / NXCD; wgid = (xcd < r ? xcd * (q + 1) : r * (q + 1) + (xcd - r) * q) + off; }
        const int nig = WGM * nN, gid = wgid / nig, fm = gid * WGM, gsz = (nM - fm) < WGM ? (nM - fm) : WGM;
        u.pm = fm + ((wgid % nig) % gsz); u.pn = (wgid % nig) / gsz; return true;
    }
    __device__ __forceinline__ void a_ready(const Unit&) const {}
    __device__ __forceinline__ void done(const Unit&) const {}
};

typedef __bf16 bf16x2_t __attribute__((ext_vector_type(2)));
typedef float f32x2_t __attribute__((ext_vector_type(2)));
__device__ __forceinline__ unsigned cvt_pk_bf16(float lo, float hi) { const f32x2_t v = {lo, hi}; const bf16x2_t r = __builtin_convertvector(v, bf16x2_t); return __builtin_bit_cast(unsigned, r); }

struct EpiBf16 {
    static constexpr bool PERM = true, AFTER_DRAIN = false;
    bf16_t* O; int ldc, pad;
    __device__ __forceinline__ void operator()(const f32x4 (&acc)[2][2][4][2], const Unit& u, int wr, int wc, int fr, int fq) const {
        const int row0 = u.pm * BM + wr * 64 + fr; const int col0 = u.pn * BM + wc * 32 + 8 * fq;
#pragma unroll
        for (int ai = 0; ai < 2; ++ai)
#pragma unroll
            for (int m = 0; m < 4; ++m) { bf16_t* rowp = O + (size_t)(row0 + ai * HALF + m * 16) * ldc + col0;
#pragma unroll
                for (int bj = 0; bj < 2; ++bj) { const f32x4 v0 = acc[ai][bj][m][0], v1 = acc[ai][bj][m][1];
                    u32x4 w; w.x = cvt_pk_bf16(v0[0], v0[1]); w.y = cvt_pk_bf16(v0[2], v0[3]); w.z = cvt_pk_bf16(v1[0], v1[1]); w.w = cvt_pk_bf16(v1[2], v1[3]);
                    *(u32x4*)(rowp + bj * HALF) = w; } }
    }
};
struct EpiResF32 {
    static constexpr bool PERM = false, AFTER_DRAIN = false;
    const float* base; float* out; int ldc, pad;
    __device__ __forceinline__ void operator()(const f32x4 (&acc)[2][2][4][2], const Unit& u, int wr, int wc, int fr, int fq) const {
        const int row0 = u.pm * BM + wr * 64 + fr, col0 = u.pn * BM + wc * 32 + 4 * fq;
#pragma unroll
        for (int ai = 0; ai < 2; ++ai)
#pragma unroll
            for (int m = 0; m < 4; ++m) { const size_t off = (size_t)(row0 + ai * HALF + m * 16) * ldc + col0;
#pragma unroll
                for (int bj = 0; bj < 2; ++bj)
#pragma unroll
                    for (int n = 0; n < 2; ++n) { const f32x4 bs = *(const f32x4*)(base + off + bj * HALF + n * 16); *(f32x4*)(out + off + bj * HALF + n * 16) = bs + acc[ai][bj][m][n]; } }
    }
};

template <class Epi, class Sched, bool ALIGN_EPI = false, bool SP2 = false>
__device__ __forceinline__ void gemm_phase(PG8_LAS unsigned char* lds, const Gemm g, const Sched& S, const Epi& E) {
    const int tid = threadIdx.x, wid = __builtin_amdgcn_readfirstlane(tid >> 6), lane = tid & 63, wr = wid >> 2, wc = wid & 3, fr = lane & 15, fq = lane >> 4;
    const int K = g.K, nt = K / BK;
    unsigned voffA[2], voffB[2];
#pragma unroll
    for (int i = 0; i < 2; ++i) { int R, C; stage_rc(tid * 16 + i * 8192, R, C); const int Rb = Epi::PERM ? ((R & ~31) + perm32(R & 31)) : R;
        voffA[i] = (unsigned)(R * K + C) * 2u; voffB[i] = (unsigned)(Rb * K + C) * 2u; }
    const size_t kstep = (size_t)(BK * 2);
    const size_t hstep = (size_t)HALF * K * 2;
    const size_t tstep = 2 * hstep;
    const unsigned ldsw = (unsigned)wid * 1024u;
    const int aoff = lds_byte(wr * 64 + fr, fq * 8), boff = lds_byte(wc * 32 + fr, fq * 8);
#define PG8_SA(b, h) (((b) * 2 + (h)) * HTB)
#define PG8_SB(b, h) ((4 + (b) * 2 + (h)) * HTB)
#define PG8_STAGE(bufoff, gbase, voff) do { _Pragma("unroll") for (int _i = 0; _i < 2; ++_i) \
        __builtin_amdgcn_global_load_lds((const unsigned*)((const char*)(gbase) + (voff)[_i]), (PG8_LAS unsigned*)(lds + (bufoff) + ldsw + _i * 8192), 16, 0, 0); } while (0)
#define PG8_LDA(dst, b, h) do { _Pragma("unroll") for (int m = 0; m < 4; ++m) _Pragma("unroll") for (int k = 0; k < 2; ++k) dst[m][k] = *(const PG8_LAS bf16x8*)(lds + PG8_SA(b, h) + aoff + m * 2048 + k * 1024); } while (0)
#define PG8_LDB(dst, b, h) do { _Pragma("unroll") for (int n = 0; n < 2; ++n) _Pragma("unroll") for (int k = 0; k < 2; ++k) dst[n][k] = *(const PG8_LAS bf16x8*)(lds + PG8_SB(b, h) + boff + n * 2048 + k * 1024); } while (0)
#define PG8_MMA(ai, bj, At, Bt) do { __builtin_amdgcn_s_setprio(1); _Pragma("unroll") for (int m = 0; m < 4; ++m) _Pragma("unroll") for (int n = 0; n < 2; ++n) _Pragma("unroll") for (int k = 0; k < 2; ++k) \
        acc[ai][bj][m][n] = __builtin_amdgcn_mfma_f32_16x16x32_bf16(Bt[n][k], At[m][k], acc[ai][bj][m][n], 0, 0, 0); __builtin_amdgcn_s_setprio(0); } while (0)
#define PG8_WAIT_V(n) asm volatile("s_waitcnt vmcnt(" #n ")" ::: "memory")
#define PG8_WAIT_L(n) asm volatile("s_waitcnt lgkmcnt(" #n ")" ::: "memory")
#define PG8_BAR __builtin_amdgcn_s_barrier()
#define PG8_SCHED __builtin_amdgcn_sched_barrier(0)
    Unit cur, nxt; int ui = 0;
    if (!S.next(0, cur)) return;
    f32x4 acc[2][2][4][2];
#pragma unroll
    for (int a = 0; a < 2; ++a)
#pragma unroll
        for (int b = 0; b < 2; ++b)
#pragma unroll
            for (int m = 0; m < 4; ++m)
#pragma unroll
                for (int n = 0; n < 2; ++n) acc[a][b][m][n] = (f32x4){0.f, 0.f, 0.f, 0.f};
    bf16x8 At[4][2], B0[2][2], B1[2][2];
    const char* cA = (const char*)g.A + (size_t)cur.pm * tstep; const char* cB = (const char*)g.Bt + (size_t)cur.pn * tstep;
    S.a_ready(cur);
    if constexpr (SP2) {
        PG8_STAGE(PG8_SB(0, 0), cB, voffB); PG8_STAGE(PG8_SB(0, 1), cB + hstep, voffB); PG8_STAGE(PG8_SA(0, 0), cA, voffA); PG8_STAGE(PG8_SA(0, 1), cA + hstep, voffA);
        if (wr == 1) PG8_BAR;
        PG8_WAIT_V(2); PG8_BAR;
        PG8_STAGE(PG8_SB(1, 0), cB + kstep, voffB); PG8_STAGE(PG8_SA(1, 0), cA + kstep, voffA); PG8_STAGE(PG8_SB(1, 1), cB + hstep + kstep, voffB);
        PG8_WAIT_V(6); PG8_BAR;
    } else {
        PG8_STAGE(PG8_SB(0, 0), cB, voffB); PG8_STAGE(PG8_SA(0, 0), cA, voffA); PG8_STAGE(PG8_SB(0, 1), cB + hstep, voffB); PG8_STAGE(PG8_SA(0, 1), cA + hstep, voffA);
        if (wr == 1) PG8_BAR;
        PG8_WAIT_V(4); PG8_BAR;
        PG8_STAGE(PG8_SB(1, 0), cB + kstep, voffB); PG8_STAGE(PG8_SA(1, 0), cA + kstep, voffA); PG8_STAGE(PG8_SB(1, 1), cB + hstep + kstep, voffB);
        PG8_WAIT_V(6); PG8_BAR;
    }
    for (;;) {
        const bool has_next = S.next(ui + 1, nxt);
        const char* nA = has_next ? (const char*)g.A + (size_t)nxt.pm * tstep : cA; const char* nB = has_next ? (const char*)g.Bt + (size_t)nxt.pn * tstep : cB;
        for (int t = 0; t < nt; t += 2) {
            const bool last = (t == nt - 2);
            const char* a1 = cA + (size_t)(t + 1) * kstep;
            const char* a2 = last ? nA : cA + (size_t)(t + 2) * kstep; const char* b2 = last ? nB : cB + (size_t)(t + 2) * kstep;
            const char* a3 = a2 + kstep; const char* b3 = b2 + kstep;
            if (last && has_next) S.a_ready(nxt);
            if constexpr (SP2) {
            PG8_LDB(B0, 0, 0); PG8_LDB(B1, 0, 1); PG8_SCHED; PG8_LDA(At, 0, 0); PG8_STAGE(PG8_SA(1, 1), a1 + hstep, voffA);
            PG8_WAIT_V(8); PG8_WAIT_L(0); PG8_BAR; PG8_MMA(0, 0, At, B0); PG8_MMA(0, 1, At, B1); PG8_BAR; PG8_SCHED;
            PG8_LDA(At, 0, 1); PG8_STAGE(PG8_SB(0, 0), b2, voffB); PG8_STAGE(PG8_SB(0, 1), b2 + hstep, voffB); PG8_STAGE(PG8_SA(0, 0), a2, voffA);
            PG8_WAIT_V(8); PG8_WAIT_L(0); PG8_BAR; PG8_MMA(1, 0, At, B0); PG8_MMA(1, 1, At, B1); PG8_BAR; PG8_SCHED;
            PG8_LDB(B0, 1, 0); PG8_LDB(B1, 1, 1); PG8_SCHED; PG8_LDA(At, 1, 0); PG8_STAGE(PG8_SA(0, 1), a2 + hstep, voffA);
            PG8_WAIT_V(8); PG8_WAIT_L(0); PG8_BAR; PG8_MMA(0, 0, At, B0); PG8_MMA(0, 1, At, B1); PG8_BAR; PG8_SCHED;
            PG8_LDA(At, 1, 1); PG8_STAGE(PG8_SB(1, 0), b3, voffB); PG8_STAGE(PG8_SB(1, 1), b3 + hstep, voffB); PG8_STAGE(PG8_SA(1, 0), a3, voffA);
            PG8_WAIT_V(8); PG8_WAIT_L(0); PG8_BAR; PG8_MMA(1, 0, At, B0); PG8_MMA(1, 1, At, B1); PG8_BAR; PG8_SCHED;
            } else {
            PG8_LDB(B0, 0, 0); PG8_SCHED; PG8_LDA(At, 0, 0); PG8_STAGE(PG8_SA(1, 1), a1 + hstep, voffA);
            PG8_WAIT_L(8); PG8_BAR; PG8_WAIT_L(0); PG8_MMA(0, 0, At, B0); PG8_BAR; PG8_SCHED;
            PG8_LDB(B1, 0, 1); PG8_STAGE(PG8_SB(0, 0), b2, voffB);
            PG8_BAR; PG8_WAIT_L(0); PG8_MMA(0, 1, At, B1); PG8_BAR;
            PG8_LDA(At, 0, 1); PG8_STAGE(PG8_SA(0, 0), a2, voffA);
            PG8_BAR; PG8_WAIT_L(0); PG8_MMA(1, 0, At, B0); PG8_BAR; PG8_SCHED;
            PG8_STAGE(PG8_SB(0, 1), b2 + hstep, voffB);
            PG8_WAIT_V(6); PG8_BAR; PG8_MMA(1, 1, At, B1); PG8_BAR;
            PG8_LDB(B0, 1, 0); PG8_SCHED; PG8_LDA(At, 1, 0); PG8_STAGE(PG8_SA(0, 1), a2 + hstep, voffA);
            PG8_WAIT_L(8); PG8_BAR; PG8_WAIT_L(0); PG8_MMA(0, 0, At, B0); PG8_BAR; PG8_SCHED;
            PG8_LDB(B1, 1, 1); PG8_STAGE(PG8_SB(1, 0), b3, voffB);
            PG8_BAR; PG8_WAIT_L(0); PG8_MMA(0, 1, At, B1); PG8_BAR;
            PG8_LDA(At, 1, 1); PG8_STAGE(PG8_SA(1, 0), a3, voffA);
            PG8_BAR; PG8_WAIT_L(0); PG8_MMA(1, 0, At, B0); PG8_BAR; PG8_SCHED;
            PG8_STAGE(PG8_SB(1, 1), b3 + hstep, voffB);
            PG8_WAIT_V(6); PG8_BAR; PG8_MMA(1, 1, At, B1); PG8_BAR;
            }
        }
        if constexpr (ALIGN_EPI) { if (wr == 0) PG8_BAR; }
        if constexpr (!Epi::AFTER_DRAIN) { E(acc, cur, wr, wc, fr, fq); S.done(cur); }
        if (!has_next) break;
#pragma unroll
        for (int a = 0; a < 2; ++a)
#pragma unroll
            for (int b = 0; b < 2; ++b)
#pragma unroll
                for (int m = 0; m < 4; ++m)
#pragma unroll
                    for (int n = 0; n < 2; ++n) acc[a][b][m][n] = (f32x4){0.f, 0.f, 0.f, 0.f};
        cur = nxt; cA = nA; cB = nB; ++ui;
        if constexpr (ALIGN_EPI) { if (wr == 1) PG8_BAR; }
    }
    PG8_WAIT_V(0);
    if constexpr (!ALIGN_EPI) { if (wr == 0) PG8_BAR; }
    PG8_BAR;
#undef PG8_SA
#undef PG8_SB
#undef PG8_STAGE
#undef PG8_LDA
#undef PG8_LDB
#undef PG8_MMA
#undef PG8_WAIT_V
#undef PG8_WAIT_L
#undef PG8_BAR
#undef PG8_SCHED
}
}

typedef unsigned short bf16;
constexpr int NWAVES = 8, NT = NWAVES * 64;
constexpr int D = 1024, BATCH = 16, SEQ = 2048, NMETA = 16, TT = SEQ + NMETA;
constexpr int MROWS = BATCH * TT;
constexpr int MREAL = BATCH * SEQ;
constexpr int INCOLS = 4104, NPAD = 4352;
constexpr int C_HQ = 0, C_HF = 512, C_HI = 1024, C_HZ = 1536, C_GQKV = 2048, C_GZ = 3584, C_GA = 4096, C_GB = 4100;
constexpr float EPS = 1e-6f;

constexpr size_t MiB = 1u << 20;
constexpr size_t WS_CTL = 0, CTL_ZERO_BYTES = 64 * 1024;
constexpr size_t WS_WIN = 2 * MiB, WS_WOUT = 12 * MiB, WS_U = 16 * MiB, WS_Y = 16 * MiB  , WS_PROJ = 96 * MiB, WS_GREC = 372 * MiB, WS_END = 512 * MiB;
constexpr int RING_BYTES = 131072, LDS_BYTES = 163840, MISC_OFF = LDS_BYTES - 512;

#define LAS __attribute__((address_space(3)))
__device__ __forceinline__ unsigned f2bf(float f) { unsigned u = __builtin_bit_cast(unsigned, f); return (u + 0x7fffu + ((u >> 16) & 1u)) >> 16; }
__device__ __forceinline__ float bf2f(bf16 h) { return __builtin_bit_cast(float, (unsigned)h << 16); }
__device__ __forceinline__ float wave_sum(float v) {
#pragma unroll
    for (int o = 1; o < 64; o <<= 1) v += __shfl_xor(v, o);
    return v;
}
__device__ __forceinline__ float sigmoidf_(float x) { return 1.f / (1.f + __expf(-x)); }
__device__ __forceinline__ float siluf_(float x) { return x / (1.f + __expf(-x)); }

#define XB_TMO      128
#define XB_XCNT(j)  (256  + 64 * (j))
#define XB_XSUB(j)  (1280 + 64 * (j))
#define XB_XGEN(j)  (2304 + 64 * (j))
#define XB_TOP      3328
#define XB_TOPGEN   3392
#define XCD_BAR_WORDS 3456
#define XB_SPIN_CAP (1u << 18)
__device__ __forceinline__ unsigned xb_ld(unsigned* p)              { return __hip_atomic_load(p, __ATOMIC_RELAXED, __HIP_MEMORY_SCOPE_AGENT); }
__device__ __forceinline__ unsigned xb_add(unsigned* p, unsigned v) { return __hip_atomic_fetch_add(p, v, __ATOMIC_RELAXED, __HIP_MEMORY_SCOPE_AGENT); }
__device__ __forceinline__ unsigned xb_xcc_id() { return (unsigned)__builtin_amdgcn_s_getreg((3 << 11) | 20) & 0xFu; }
#define XB_SPIN(cond, bar) do { unsigned _sp = 0; while (cond) { __builtin_amdgcn_s_sleep(1); \
    if ((++_sp & 255u) == 0u) { if (xb_ld(&(bar)[XB_TMO])) break; if (_sp > XB_SPIN_CAP) { atomicAdd(&(bar)[XB_TMO], 1u); break; } } } } while (0)
struct XcdBarrier { unsigned* bar; unsigned x; volatile LAS unsigned* st; };
__device__ __forceinline__ XcdBarrier xcd_barrier_post(unsigned* bar, volatile LAS unsigned* st) {
    XcdBarrier b; b.bar = bar; b.x = xb_xcc_id(); b.st = st;
    if (threadIdx.x == 0) (void)xb_add(&bar[XB_XCNT(b.x)], 1u);
    return b;
}
__device__ __forceinline__ void xcd_barrier_complete(unsigned* bar, unsigned x, unsigned& nloc, unsigned& nx) {
    const unsigned G = gridDim.x * gridDim.y * gridDim.z;
    unsigned sum, cnt, mine, sp = 0u;
    for (;;) {
        sum = 0u; cnt = 0u; mine = 0u;
#pragma unroll
        for (unsigned j = 0; j < 16; ++j) { const unsigned c = xb_ld(&bar[XB_XCNT(j)]); sum += c; cnt += (c > 0u) ? 1u : 0u; mine = (j == x) ? c : mine; }
        if (sum == G) break;
        __builtin_amdgcn_s_sleep(1);
        if ((++sp & 255u) == 0u) { if (xb_ld(&bar[XB_TMO])) break; if (sp > XB_SPIN_CAP) { atomicAdd(&bar[XB_TMO], 1u); break; } }
    }
    nloc = mine > 0u ? mine : 1u; nx = cnt > 0u ? cnt : 1u;
}
__device__ __forceinline__ void xcd_barrier(const XcdBarrier& b) {
    asm volatile("s_waitcnt vmcnt(0)" ::: "memory");
    __syncthreads();
    if (threadIdx.x == 0) {
        unsigned* bar = b.bar;
        __builtin_amdgcn_s_waitcnt(0);
        unsigned nloc = b.st[0], nx = b.st[1];
        if (nloc == 0u) { xcd_barrier_complete(bar, b.x, nloc, nx); b.st[0] = nloc; b.st[1] = nx; }
        const unsigned old = xb_add(&bar[XB_XSUB(b.x)], 1u);
        const unsigned gen = old / nloc;
        if (old + 1u == (gen + 1u) * nloc) {
            __builtin_amdgcn_fence(__ATOMIC_RELEASE, "agent");
            asm volatile("s_waitcnt vmcnt(0)" ::: "memory");
            const unsigned og = xb_add(&bar[XB_TOP], 1u);
            const unsigned tg = og / nx;
            if (og + 1u == (tg + 1u) * nx) xb_add(&bar[XB_TOPGEN], 1u);
            else XB_SPIN(xb_ld(&bar[XB_TOPGEN]) == tg, bar);
            __builtin_amdgcn_fence(__ATOMIC_ACQUIRE, "agent");
            xb_add(&bar[XB_XGEN(b.x)], 1u);
            asm volatile("s_waitcnt vmcnt(0)" ::: "memory");
        } else {
            XB_SPIN(xb_ld(&bar[XB_XGEN(b.x)]) == gen, bar);
            __builtin_amdgcn_fence(__ATOMIC_ACQUIRE, "agent");
            asm volatile("s_waitcnt vmcnt(0)" ::: "memory");
        }
    }
    __syncthreads();
}

__device__ __forceinline__ void p_norm_in(const float* x, const float* meta, const float* norm_w, bf16* U, int gw, int NGW, int lane) {
    for (int r = gw; r < MROWS; r += NGW) {
        const int b = r / TT, t = r % TT;
        const float* src = (t < NMETA) ? meta + (size_t)t * D : x + ((size_t)b * SEQ + (t - NMETA)) * D;
        float4 v[4]; float s = 0.f;
#pragma unroll
        for (int j = 0; j < 4; ++j) { v[j] = ((const float4*)src)[lane + 64 * j]; s += v[j].x * v[j].x + v[j].y * v[j].y + v[j].z * v[j].z + v[j].w * v[j].w; }
        const float rstd = rsqrtf(wave_sum(s) * (1.f / D) + EPS);
#pragma unroll
        for (int j = 0; j < 4; ++j) { const float4 w = ((const float4*)norm_w)[lane + 64 * j];
            uint2 o; o.x = f2bf(v[j].x * rstd * w.x) | (f2bf(v[j].y * rstd * w.y) << 16); o.y = f2bf(v[j].z * rstd * w.z) | (f2bf(v[j].w * rstd * w.w) << 16);
            ((uint2*)(U + (size_t)r * D))[lane + 64 * j] = o; }
    }
}
__device__ __forceinline__ void p_transpose_item(const float* W, int K, int N, bf16* WT, LAS float* scr, int item, int lane) {
    const int nblk = (N + 31) / 32; const int kb = item / nblk, nb = item % nblk, k0 = 64 * kb, n0 = 32 * nb;
    const int nn = n0 + (lane & 31);
#pragma unroll 8
    for (int i = 0; i < 32; ++i) { const int kk = 2 * i + (lane >> 5); scr[kk * 33 + (lane & 31)] = (nn < N) ? W[(size_t)(k0 + kk) * N + nn] : 0.f; }
    asm volatile("s_waitcnt lgkmcnt(0)" ::: "memory");
    const int c = lane & 7;
#pragma unroll
    for (int j = 0; j < 4; ++j) { const int n = (lane >> 3) + 8 * j; const LAS float* sp = scr + (8 * c) * 33 + n;
        uint4 o; o.x = f2bf(sp[0 * 33]) | (f2bf(sp[1 * 33]) << 16); o.y = f2bf(sp[2 * 33]) | (f2bf(sp[3 * 33]) << 16); o.z = f2bf(sp[4 * 33]) | (f2bf(sp[5 * 33]) << 16); o.w = f2bf(sp[6 * 33]) | (f2bf(sp[7 * 33]) << 16);
        *(uint4*)(WT + (size_t)(n0 + n) * K + k0 + 8 * c) = o; }
    asm volatile("s_waitcnt lgkmcnt(0)" ::: "memory");
}

#ifndef SK_PG
#define SK_PG 0
#endif
#ifndef SK_PH
#define SK_PH 0
#endif
#ifndef SK_SH
#define SK_SH 0
#endif
#ifndef SK_SG
#define SK_SG 0
#endif
#ifndef SK_G1
#define SK_G1 0
#endif
#ifndef XS1
#define XS1 0
#endif
#ifndef XS2
#define XS2 0
#endif
#ifndef XS3
#define XS3 0
#endif
#ifndef NEW_H
#define NEW_H 1
#endif
#ifndef NEW_G
#define NEW_G 1
#endif
typedef short bf16x8 __attribute__((ext_vector_type(8)));
typedef float f32x16 __attribute__((ext_vector_type(16)));
typedef float f32x4 __attribute__((ext_vector_type(4)));
typedef unsigned u32x2 __attribute__((ext_vector_type(2)));
#define FNMA(d, a, b) asm volatile("v_fma_f32 %0, -%1, %2, %0" : "+v"(d) : "v"(a), "v"(b))
#define WLF() asm volatile("s_waitcnt lgkmcnt(0)" ::: "memory")
#define MFMA32(a, b, c) __builtin_amdgcn_mfma_f32_32x32x16_bf16((a), (b), (c), 0, 0, 0)
constexpr int NCH = 65;
constexpr int HREC_QS = 0, HREC_KLT = 8192, HREC_VT = 16384, HREC_AS = 24576, HREC_ET = 26624, HREC_BYTES = 27136;
constexpr int GREC_WN = 0, GREC_UT = 8192, GREC_QG = 16384, GREC_KGT = 24576, GREC_QKM = 32768, GREC_EGL = 34816, GREC_BYTES = 34880;
__device__ __forceinline__ float bflo(unsigned u) { return __builtin_bit_cast(float, u << 16); }
__device__ __forceinline__ float bfhi(unsigned u) { return __builtin_bit_cast(float, u & 0xffff0000u); }
__device__ __forceinline__ unsigned pk2(float lo, float hi) { return pg8::cvt_pk_bf16(lo, hi); }
__device__ __forceinline__ int crow(int i, int hh) { return (i & 3) + 8 * (i >> 2) + 4 * hh; }
__device__ __forceinline__ size_t rec_index(int b, int h, int c) { return (size_t)((c == 0 ? 0 : b) * 4 + h) * NCH + c; }

template <bool META>
__device__ __forceinline__ void prep_hgrn2(LAS unsigned char* wl, int b, int h, int c, const bf16* P, const float* lb_logits, unsigned char* rec, int lane) {
    LAS unsigned* Qs = (LAS unsigned*)wl; LAS unsigned* Kd = (LAS unsigned*)(wl + 8704);
    const int d0 = 2 * lane, r = lane & 31, hh = lane >> 5;
    const float lb0 = 1.f / (1.f + __expf(lb_logits[512 + h * 128 + d0] - lb_logits[h * 128 + d0]));
    const float lb1 = 1.f / (1.f + __expf(lb_logits[512 + h * 128 + d0 + 1] - lb_logits[h * 128 + d0 + 1]));
    float G0 = 0.f, G1 = 0.f; float lf0[32], lf1[32]; unsigned kb[32]; unsigned vt0[16], vt1[16];
    unsigned* qs_rec = (unsigned*)(rec + HREC_QS);
#pragma unroll
    for (int tb = 0; tb < 4; ++tb) {
        unsigned qr[8], fr[8], vr[8];
#pragma unroll
        for (int i = 0; i < 8; ++i) { const int e = 32 * c + 8 * tb + i; const bool valid = !META || e >= 16;
            const unsigned* p = (const unsigned*)(P + (size_t)(b * TT + (valid ? e - 16 : 0)) * NPAD + h * 128 + d0);
            qr[i] = valid ? p[C_HQ / 2] : 0u; fr[i] = valid ? p[C_HF / 2] : 0u; vr[i] = valid ? p[C_HI / 2] : 0u; }
#pragma unroll
        for (int i = 0; i < 8; ++i) { const int t = 8 * tb + i; const bool valid = !META || (32 * c + t) >= 16;
            float f0 = lb0 + (1.f - lb0) * sigmoidf_(bflo(fr[i])), f1 = lb1 + (1.f - lb1) * sigmoidf_(bfhi(fr[i]));
            float l0 = __logf(f0), l1 = __logf(f1), k0 = 1.f - f0, k1 = 1.f - f1;
            if (!valid) { l0 = 0.f; l1 = 0.f; k0 = 0.f; k1 = 0.f; }
            G0 += l0; G1 += l1; lf0[t] = l0; lf1[t] = l1; kb[t] = pk2(k0, k1);
            const float q0 = valid ? siluf_(bflo(qr[i])) : 0.f, q1 = valid ? siluf_(bfhi(qr[i])) : 0.f;
            const unsigned qs = pk2(q0 * __expf(G0), q1 * __expf(G1));
            Qs[t * 68 + lane] = qs; qs_rec[t * 64 + lane] = qs;
            Kd[t * 68 + lane] = pk2(k0 * __expf(-G0), k1 * __expf(-G1));
            if ((t & 1) == 0) { vt0[t >> 1] = vr[i] & 0xffffu; vt1[t >> 1] = vr[i] >> 16; }
            else { vt0[t >> 1] |= vr[i] << 16; vt1[t >> 1] |= vr[i] & 0xffff0000u; } }
    }
    { float2 et; et.x = __expf(G0); et.y = __expf(G1); *(float2*)(rec + HREC_ET + d0 * 4) = et; }
    unsigned kl0[16], kl1[16]; float R0 = 0.f, R1 = 0.f;
#pragma unroll
    for (int j = 15; j >= 0; --j) {
        const float a0 = bflo(kb[2 * j + 1]) * __expf(R0), a1 = bfhi(kb[2 * j + 1]) * __expf(R1); R0 += lf0[2 * j + 1]; R1 += lf1[2 * j + 1];
        const float b0 = bflo(kb[2 * j]) * __expf(R0), b1 = bfhi(kb[2 * j]) * __expf(R1); R0 += lf0[2 * j]; R1 += lf1[2 * j];
        kl0[j] = pk2(b0, a0); kl1[j] = pk2(b1, a1); }
#pragma unroll
    for (int j = 0; j < 4; ++j) {
        *(uint4*)(rec + HREC_KLT + d0 * 64 + j * 16) = make_uint4(kl0[4 * j], kl0[4 * j + 1], kl0[4 * j + 2], kl0[4 * j + 3]);
        *(uint4*)(rec + HREC_KLT + (d0 + 1) * 64 + j * 16) = make_uint4(kl1[4 * j], kl1[4 * j + 1], kl1[4 * j + 2], kl1[4 * j + 3]);
        *(uint4*)(rec + HREC_VT + d0 * 64 + j * 16) = make_uint4(vt0[4 * j], vt0[4 * j + 1], vt0[4 * j + 2], vt0[4 * j + 3]);
        *(uint4*)(rec + HREC_VT + (d0 + 1) * 64 + j * 16) = make_uint4(vt1[4 * j], vt1[4 * j + 1], vt1[4 * j + 2], vt1[4 * j + 3]); }
    WLF();
    f32x16 acc;
#pragma unroll
    for (int i = 0; i < 16; ++i) acc[i] = 0.f;
#pragma unroll
    for (int ks = 0; ks < 8; ++ks) { const bf16x8 a = *(const LAS bf16x8*)(wl + (r * 136 + 16 * ks + 8 * hh) * 2); const bf16x8 bq = *(const LAS bf16x8*)(wl + 8704 + (r * 136 + 16 * ks + 8 * hh) * 2); acc = MFMA32(a, bq, acc); }
    bf16* as_rec = (bf16*)(rec + HREC_AS);
#pragma unroll
    for (int i = 0; i < 16; ++i) { const int t = crow(i, hh); as_rec[t * 32 + r] = (bf16)f2bf(r <= t ? acc[i] : 0.f); }
    WLF();
}

template <bool META>
__device__ __forceinline__ void prep_gdn(LAS unsigned char* wl, int b, int h, int c, const bf16* P, const float* conv_w, const float* A_log, const float* dt_bias, unsigned char* rec, int lane) {
    LAS unsigned* Ql = (LAS unsigned*)wl; LAS unsigned* Kl = (LAS unsigned*)(wl + 8704);
    LAS float* Af = (LAS float*)wl;
    LAS float* s_gam = (LAS float*)(wl + 17408); LAS float* s_beta = s_gam + 32; LAS float* s_rk = s_gam + 64; LAS float* s_rq = s_gam + 96; LAS float* s_nk = s_gam + 128; LAS float* s_nq = s_gam + 160;
    const int d0 = 2 * lane, r = lane & 31, hh = lane >> 5;
    float cw[3][4][2];
#pragma unroll
    for (int g = 0; g < 3; ++g)
#pragma unroll
        for (int j = 0; j < 4; ++j) { const float2 w2 = *(const float2*)(conv_w + j * 1536 + g * 512 + h * 128 + d0); cw[g][j][0] = w2.x; cw[g][j][1] = w2.y; }
    unsigned win[3][3];
#pragma unroll
    for (int j = 0; j < 3; ++j) { const int e = 32 * c - 3 + j; const bool valid = !META || e >= 16;
        const unsigned* p = (const unsigned*)(P + (size_t)(b * TT + (valid ? e - 16 : 0)) * NPAD + C_GQKV + h * 128 + d0);
#pragma unroll
        for (int g = 0; g < 3; ++g) win[g][j] = valid ? p[g * 256] : 0u; }
#pragma unroll
    for (int tb = 0; tb < 4; ++tb) {
        unsigned raw[8][2];
#pragma unroll
        for (int i = 0; i < 8; ++i) { const int e = 32 * c + 8 * tb + i; const bool valid = !META || e >= 16;
            const unsigned* p = (const unsigned*)(P + (size_t)(b * TT + (valid ? e - 16 : 0)) * NPAD + C_GQKV + h * 128 + d0);
#pragma unroll
            for (int g = 0; g < 2; ++g) raw[i][g] = valid ? p[g * 256] : 0u; }
#pragma unroll
        for (int i = 0; i < 8; ++i) { const int t = 8 * tb + i; unsigned o[2];
#pragma unroll
            for (int g = 0; g < 2; ++g) {
                const float a0 = cw[g][0][0] * bflo(win[g][0]) + cw[g][1][0] * bflo(win[g][1]) + cw[g][2][0] * bflo(win[g][2]) + cw[g][3][0] * bflo(raw[i][g]);
                const float a1 = cw[g][0][1] * bfhi(win[g][0]) + cw[g][1][1] * bfhi(win[g][1]) + cw[g][2][1] * bfhi(win[g][2]) + cw[g][3][1] * bfhi(raw[i][g]);
                o[g] = pk2(siluf_(a0), siluf_(a1)); win[g][0] = win[g][1]; win[g][1] = win[g][2]; win[g][2] = raw[i][g]; }
            Ql[t * 68 + lane] = o[0]; Kl[t * 68 + lane] = o[1]; }
    }
    WLF();
    { const int e = 32 * c + r; const bool valid = !META || e >= 16; const bf16* pr = P + (size_t)(b * TT + (valid ? e - 16 : 0)) * NPAD;
      const float xa = bf2f(pr[C_GA + h]) + dt_bias[h]; const float sp = (xa > 20.f) ? xa : log1pf(__expf(xa));
      float g = valid ? -__expf(A_log[h]) * sp : 0.f; const float be = valid ? sigmoidf_(bf2f(pr[C_GB + h])) : 0.f;
#pragma unroll
      for (int off = 1; off < 32; off <<= 1) { const float n = __shfl_up(g, off); if (r >= off) g += n; }
      if (lane < 32) { s_gam[r] = g; s_beta[r] = be; } }
    WLF();
    f32x16 KK, QK, QQ;
#pragma unroll
    for (int i = 0; i < 16; ++i) { KK[i] = 0.f; QK[i] = 0.f; QQ[i] = 0.f; }
#pragma unroll
    for (int ks = 0; ks < 8; ++ks) { const bf16x8 qf = *(const LAS bf16x8*)(wl + (r * 136 + 16 * ks + 8 * hh) * 2); const bf16x8 kf = *(const LAS bf16x8*)(wl + 8704 + (r * 136 + 16 * ks + 8 * hh) * 2);
        KK = MFMA32(kf, kf, KK); QK = MFMA32(qf, kf, QK); QQ = MFMA32(qf, qf, QQ); }
    { const int istar = (r & 3) + 4 * (r >> 3); float dk_ = 0.f, dq_ = 0.f;
#pragma unroll
      for (int i = 0; i < 16; ++i) { dk_ = (i == istar) ? KK[i] : dk_; dq_ = (i == istar) ? QQ[i] : dq_; }
      if (hh == ((r >> 2) & 1)) { s_nk[r] = dk_; s_nq[r] = dq_; } }
    WLF();
    if (lane < 32) { s_rk[r] = rsqrtf(s_nk[r] + EPS); s_rq[r] = rsqrtf(s_nq[r] + EPS) * 0.08838834764831845f; }
    WLF();
    const float gs = s_gam[r], rks = s_rk[r], g31 = s_gam[31];
    { unsigned* qg_rec = (unsigned*)(rec + GREC_QG);
#pragma unroll 8
      for (int t = 0; t < 32; ++t) { const unsigned qp = Ql[t * 68 + lane]; const float sc = s_rq[t] * __expf(s_gam[t]); qg_rec[t * 64 + lane] = pk2(bflo(qp) * sc, bfhi(qp) * sc); } }
    if (lane == 0) *(float*)(rec + GREC_EGL) = __expf(g31);
    WLF();
    { bf16* qkm_rec = (bf16*)(rec + GREC_QKM);
      float av[16];
#pragma unroll
      for (int i = 0; i < 16; ++i) { const int t = crow(i, hh); const float gt = s_gam[t], bt = s_beta[t], rkt = s_rk[t], rqt = s_rq[t];
          const float dec = __expf(fminf(gt - gs, 0.f));
          av[i] = (r < t) ? bt * rkt * rks * dec * KK[i] : 0.f;
          qkm_rec[t * 32 + r] = (bf16)f2bf((r <= t) ? rqt * rks * dec * QK[i] : 0.f); }
#pragma unroll
      for (int i = 0; i < 16; ++i) Af[crow(i, hh) * 36 + r] = av[i]; }
    WLF();
    { unsigned kg0[16], kg1[16];
#pragma unroll
      for (int j = 0; j < 16; ++j) { const unsigned ka = Kl[(2 * j) * 68 + lane], kc = Kl[(2 * j + 1) * 68 + lane];
          const float sa = s_rk[2 * j] * __expf(g31 - s_gam[2 * j]), sc = s_rk[2 * j + 1] * __expf(g31 - s_gam[2 * j + 1]);
          kg0[j] = pk2(bflo(ka) * sa, bflo(kc) * sc); kg1[j] = pk2(bfhi(ka) * sa, bfhi(kc) * sc); }
#pragma unroll
      for (int j = 0; j < 4; ++j) {
          *(uint4*)(rec + GREC_KGT + d0 * 64 + j * 16) = make_uint4(kg0[4 * j], kg0[4 * j + 1], kg0[4 * j + 2], kg0[4 * j + 3]);
          *(uint4*)(rec + GREC_KGT + (d0 + 1) * 64 + j * 16) = make_uint4(kg1[4 * j], kg1[4 * j + 1], kg1[4 * j + 2], kg1[4 * j + 3]); } }
    WLF();
    { float x0[32], x1[32];
#pragma unroll
      for (int tb = 0; tb < 4; ++tb) {
          unsigned rv[8];
#pragma unroll
          for (int i = 0; i < 8; ++i) { const int e = 32 * c + 8 * tb + i; const bool valid = !META || e >= 16;
              rv[i] = valid ? ((const unsigned*)(P + (size_t)(b * TT + (valid ? e - 16 : 0)) * NPAD + C_GQKV + h * 128 + d0))[512] : 0u; }
#pragma unroll
          for (int i = 0; i < 8; ++i) { const int t = 8 * tb + i;
              const float c0 = cw[2][0][0] * bflo(win[2][0]) + cw[2][1][0] * bflo(win[2][1]) + cw[2][2][0] * bflo(win[2][2]) + cw[2][3][0] * bflo(rv[i]);
              const float c1 = cw[2][0][1] * bfhi(win[2][0]) + cw[2][1][1] * bfhi(win[2][1]) + cw[2][2][1] * bfhi(win[2][2]) + cw[2][3][1] * bfhi(rv[i]);
              win[2][0] = win[2][1]; win[2][1] = win[2][2]; win[2][2] = rv[i];
              const float bt = s_beta[t]; float a0 = bt * siluf_(c0), a1 = bt * siluf_(c1);
#pragma unroll
              for (int s4 = 0; s4 < t; s4 += 4) { const f32x4 a4 = *(const LAS f32x4*)(Af + t * 36 + s4);
#pragma unroll
                  for (int q = 0; q < 4; ++q) if (s4 + q < t) { FNMA(a0, a4[q], x0[s4 + q]); FNMA(a1, a4[q], x1[s4 + q]); } }
              x0[t] = a0; x1[t] = a1; asm volatile("" ::: "memory"); __builtin_amdgcn_sched_barrier(0); } }
#pragma unroll
      for (int j = 0; j < 4; ++j) {
          *(uint4*)(rec + GREC_UT + d0 * 64 + j * 16) = make_uint4(pk2(x0[8 * j], x0[8 * j + 1]), pk2(x0[8 * j + 2], x0[8 * j + 3]), pk2(x0[8 * j + 4], x0[8 * j + 5]), pk2(x0[8 * j + 6], x0[8 * j + 7]));
          *(uint4*)(rec + GREC_UT + (d0 + 1) * 64 + j * 16) = make_uint4(pk2(x1[8 * j], x1[8 * j + 1]), pk2(x1[8 * j + 2], x1[8 * j + 3]), pk2(x1[8 * j + 4], x1[8 * j + 5]), pk2(x1[8 * j + 6], x1[8 * j + 7])); } }
    { float x0[32], x1[32]; unsigned* wn_rec = (unsigned*)(rec + GREC_WN);
#pragma unroll
      for (int t = 0; t < 32; ++t) { const float f = s_beta[t] * __expf(s_gam[t]) * s_rk[t]; const unsigned kp = Kl[t * 68 + lane]; float a0 = f * bflo(kp), a1 = f * bfhi(kp);
#pragma unroll
          for (int s4 = 0; s4 < t; s4 += 4) { const f32x4 a4 = *(const LAS f32x4*)(Af + t * 36 + s4);
#pragma unroll
              for (int q = 0; q < 4; ++q) if (s4 + q < t) { FNMA(a0, a4[q], x0[s4 + q]); FNMA(a1, a4[q], x1[s4 + q]); } }
          x0[t] = a0; x1[t] = a1; wn_rec[t * 64 + lane] = pk2(-a0, -a1); asm volatile("" ::: "memory"); __builtin_amdgcn_sched_barrier(0); } }
    WLF();
}

constexpr int SEQ_ST = 0, SEQ_UT = 34816, SEQ_OF = 45056;
__device__ __forceinline__ void seq_epilogue(LAS unsigned char* L, int b, int h, int c, int colbase, int zcol, const bf16* P, const float* nw, bf16* Y, int wave, int lane) {
    const LAS float* OF = (const LAS float*)(L + SEQ_OF);
#pragma unroll
    for (int tt = 0; tt < 4; ++tt) { const int t = 4 * wave + tt;
        const float o0 = OF[t * 132 + lane], o1 = OF[t * 132 + lane + 64];
        const float rstd = rsqrtf(wave_sum(o0 * o0 + o1 * o1) * (1.f / 128.f) + EPS);
        const bf16* pz = P + (size_t)(b * TT + 32 * c - 16 + t) * NPAD + zcol + h * 128;
        bf16* yr = Y + (size_t)(b * SEQ + 32 * (c - 1) + t) * 1024 + colbase + h * 128;
        yr[lane] = (bf16)f2bf(o0 * rstd * nw[lane] * siluf_(bf2f(pz[lane]))); yr[lane + 64] = (bf16)f2bf(o1 * rstd * nw[lane + 64] * siluf_(bf2f(pz[lane + 64]))); }
}
__device__ __forceinline__ void store_ST(LAS unsigned char* L, const f32x16& S, int dtile, int vtile, int r, int hh) {
#pragma unroll
    for (int g = 0; g < 4; ++g) { u32x2 w; w.x = pk2(S[4 * g], S[4 * g + 1]); w.y = pk2(S[4 * g + 2], S[4 * g + 3]);
        *(LAS u32x2*)(L + SEQ_ST + ((32 * vtile + r) * 136 + 32 * dtile + 8 * g + 4 * hh) * 2) = w; }
}
__device__ __forceinline__ void seq_hgrn2(LAS unsigned char* L, int b, int h, const bf16* P, const unsigned char* recs, const float* hg_norm_w, bf16* Y) {
    const int tid = threadIdx.x, lane = tid & 63, wave = __builtin_amdgcn_readfirstlane(tid >> 6), r = lane & 31, hh = lane >> 5;
    const int dtile = wave & 3, vt0 = 2 * (wave >> 2);
    for (int i = tid; i < 128 * 136 / 2; i += NT) ((LAS unsigned*)(L + SEQ_ST))[i] = 0u;
    f32x16 S0, S1;
#pragma unroll
    for (int i = 0; i < 16; ++i) { S0[i] = 0.f; S1[i] = 0.f; }
    __syncthreads();
    for (int c = 0; c < NCH; ++c) {
        const unsigned char* rec = recs + rec_index(b, h, c) * HREC_BYTES;
        { bf16x8 kf[2], vf0[2], vf1[2]; f32x4 et[4];
#pragma unroll
          for (int ks = 0; ks < 2; ++ks) { kf[ks] = *(const bf16x8*)(rec + HREC_KLT + ((32 * dtile + r) * 32 + 16 * ks + 8 * hh) * 2);
              vf0[ks] = *(const bf16x8*)(rec + HREC_VT + ((32 * vt0 + r) * 32 + 16 * ks + 8 * hh) * 2); vf1[ks] = *(const bf16x8*)(rec + HREC_VT + ((32 * (vt0 + 1) + r) * 32 + 16 * ks + 8 * hh) * 2); }
#pragma unroll
          for (int g = 0; g < 4; ++g) et[g] = *(const f32x4*)(rec + HREC_ET + (32 * dtile + 8 * g + 4 * hh) * 4);
          f32x16 o;
          if (wave < 4) {
              bf16x8 af[2], vo[2], qf[8];
#pragma unroll
              for (int ks = 0; ks < 2; ++ks) { af[ks] = *(const bf16x8*)(rec + HREC_AS + (r * 32 + 16 * ks + 8 * hh) * 2); vo[ks] = *(const bf16x8*)(rec + HREC_VT + ((32 * wave + r) * 32 + 16 * ks + 8 * hh) * 2); }
#pragma unroll
              for (int ks = 0; ks < 8; ++ks) qf[ks] = *(const bf16x8*)(rec + HREC_QS + (r * 128 + 16 * ks + 8 * hh) * 2);
#pragma unroll
              for (int i = 0; i < 16; ++i) o[i] = 0.f;
#pragma unroll
              for (int ks = 0; ks < 2; ++ks) o = MFMA32(af[ks], vo[ks], o);
#pragma unroll
              for (int ks = 0; ks < 8; ++ks) { const bf16x8 sf = *(const LAS bf16x8*)(L + SEQ_ST + ((32 * wave + r) * 136 + 16 * ks + 8 * hh) * 2); o = MFMA32(qf[ks], sf, o); }
          }
#pragma unroll
          for (int i = 0; i < 16; ++i) { S0[i] *= et[i >> 2][i & 3]; S1[i] *= et[i >> 2][i & 3]; }
#pragma unroll
          for (int ks = 0; ks < 2; ++ks) { S0 = MFMA32(kf[ks], vf0[ks], S0); S1 = MFMA32(kf[ks], vf1[ks], S1); }
          __syncthreads();
          store_ST(L, S0, dtile, vt0, r, hh); store_ST(L, S1, dtile, vt0 + 1, r, hh);
          if (wave < 4) { LAS float* OF = (LAS float*)(L + SEQ_OF);
#pragma unroll
              for (int i = 0; i < 16; ++i) OF[crow(i, hh) * 132 + 32 * wave + r] = o[i]; }
        }
        __syncthreads();
        if (c >= 1) seq_epilogue(L, b, h, c, 0, C_HZ, P, hg_norm_w, Y, wave, lane);
    }
}
__device__ __forceinline__ void seq_gdn(LAS unsigned char* L, int b, int h, const bf16* P, const unsigned char* recs, const float* gdn_norm_w, bf16* Y) {
    const int tid = threadIdx.x, lane = tid & 63, wave = __builtin_amdgcn_readfirstlane(tid >> 6), r = lane & 31, hh = lane >> 5;
    const int dtile = wave & 3, vt0 = 2 * (wave >> 2), ct = wave & 3;
    for (int i = tid; i < 128 * 136 / 2; i += NT) ((LAS unsigned*)(L + SEQ_ST))[i] = 0u;
    f32x16 S0, S1;
#pragma unroll
    for (int i = 0; i < 16; ++i) { S0[i] = 0.f; S1[i] = 0.f; }
    bf16x8 idf[2];
#pragma unroll
    for (int ks = 0; ks < 2; ++ks)
#pragma unroll
        for (int j = 0; j < 8; ++j) idf[ks][j] = (16 * ks + 8 * hh + j == r) ? (short)0x3f80 : (short)0;
    __syncthreads();
    for (int c = 0; c < NCH; ++c) {
        const unsigned char* rec = recs + rec_index(b, h, c) * GREC_BYTES;
        bf16x8 kg[2];
#pragma unroll
        for (int ks = 0; ks < 2; ++ks) kg[ks] = *(const bf16x8*)(rec + GREC_KGT + ((32 * dtile + r) * 32 + 16 * ks + 8 * hh) * 2);
        const float egl = *(const float*)(rec + GREC_EGL);
        f32x16 acc;
#pragma unroll
        for (int i = 0; i < 16; ++i) acc[i] = 0.f;
        bf16x8 qkm[2];
        if (wave < 4) {
            bf16x8 uf[2], wf[8];
#pragma unroll
            for (int ks = 0; ks < 2; ++ks) uf[ks] = *(const bf16x8*)(rec + GREC_UT + ((32 * ct + r) * 32 + 16 * ks + 8 * hh) * 2);
#pragma unroll
            for (int ks = 0; ks < 8; ++ks) wf[ks] = *(const bf16x8*)(rec + GREC_WN + (r * 128 + 16 * ks + 8 * hh) * 2);
#pragma unroll
            for (int ks = 0; ks < 2; ++ks) acc = MFMA32(idf[ks], uf[ks], acc);
#pragma unroll
            for (int ks = 0; ks < 8; ++ks) { const bf16x8 sf = *(const LAS bf16x8*)(L + SEQ_ST + ((32 * ct + r) * 136 + 16 * ks + 8 * hh) * 2); acc = MFMA32(wf[ks], sf, acc); }
#pragma unroll
            for (int g = 0; g < 4; ++g) { u32x2 w; w.x = pk2(acc[4 * g], acc[4 * g + 1]); w.y = pk2(acc[4 * g + 2], acc[4 * g + 3]);
                *(LAS u32x2*)(L + SEQ_UT + ((32 * ct + r) * 40 + 8 * g + 4 * hh) * 2) = w; }
        } else {
            bf16x8 qf[8];
#pragma unroll
            for (int ks = 0; ks < 2; ++ks) qkm[ks] = *(const bf16x8*)(rec + GREC_QKM + (r * 32 + 16 * ks + 8 * hh) * 2);
#pragma unroll
            for (int ks = 0; ks < 8; ++ks) qf[ks] = *(const bf16x8*)(rec + GREC_QG + (r * 128 + 16 * ks + 8 * hh) * 2);
#pragma unroll
            for (int ks = 0; ks < 8; ++ks) { const bf16x8 sf = *(const LAS bf16x8*)(L + SEQ_ST + ((32 * ct + r) * 136 + 16 * ks + 8 * hh) * 2); acc = MFMA32(qf[ks], sf, acc); }
        }
        __syncthreads();
#pragma unroll
        for (int i = 0; i < 16; ++i) { S0[i] *= egl; S1[i] *= egl; }
#pragma unroll
        for (int ks = 0; ks < 2; ++ks) {
            const bf16x8 u0 = *(const LAS bf16x8*)(L + SEQ_UT + ((32 * vt0 + r) * 40 + 16 * ks + 8 * hh) * 2), u1 = *(const LAS bf16x8*)(L + SEQ_UT + ((32 * (vt0 + 1) + r) * 40 + 16 * ks + 8 * hh) * 2);
            S0 = MFMA32(kg[ks], u0, S0); S1 = MFMA32(kg[ks], u1, S1); }
        store_ST(L, S0, dtile, vt0, r, hh); store_ST(L, S1, dtile, vt0 + 1, r, hh);
        if (wave >= 4) {
#pragma unroll
            for (int ks = 0; ks < 2; ++ks) { const bf16x8 uo = *(const LAS bf16x8*)(L + SEQ_UT + ((32 * ct + r) * 40 + 16 * ks + 8 * hh) * 2); acc = MFMA32(qkm[ks], uo, acc); }
            LAS float* OF = (LAS float*)(L + SEQ_OF);
#pragma unroll
            for (int i = 0; i < 16; ++i) OF[crow(i, hh) * 132 + 32 * ct + r] = acc[i];
        }
        __syncthreads();
        if (c >= 1) seq_epilogue(L, b, h, c, 512, C_GZ, P, gdn_norm_w, Y, wave, lane);
    }
}
__device__ __forceinline__ void p_norm_out(float* out, const float* w, int gw, int NGW, int lane) {
    for (int r = gw; r < MREAL; r += NGW) {
        float4* p = (float4*)(out + (size_t)r * D); float4 v[4]; float s = 0.f;
#pragma unroll
        for (int j = 0; j < 4; ++j) { v[j] = p[lane + 64 * j]; s += v[j].x * v[j].x + v[j].y * v[j].y + v[j].z * v[j].z + v[j].w * v[j].w; }
        const float rstd = rsqrtf(wave_sum(s) * (1.f / D) + EPS);
#pragma unroll
        for (int j = 0; j < 4; ++j) { const float4 ww = ((const float4*)w)[lane + 64 * j]; float4 o; o.x = v[j].x * rstd * ww.x; o.y = v[j].y * rstd * ww.y; o.z = v[j].z * rstd * ww.z; o.w = v[j].w * rstd * ww.w; p[lane + 64 * j] = o; }
    }
}

struct Args { const float* in[12]; float* out; unsigned char* ws; };
__global__ void __launch_bounds__(NT, 2) fwd_megakernel(Args args) {
    extern __shared__ __attribute__((aligned(16))) unsigned char lds[];
    LAS unsigned char* L = (LAS unsigned char*)lds;
    volatile LAS unsigned* MISC = (volatile LAS unsigned*)(L + MISC_OFF);
    const int tid = threadIdx.x, lane = tid & 63, wave = __builtin_amdgcn_readfirstlane(tid >> 6);
    const int G = gridDim.x; const int bx = blockIdx.x; const int vcu = (G % 8 == 0) ? (bx % 8) * (G / 8) + bx / 8 : bx;
    const float* x = args.in[0]; const float* meta = args.in[1]; const float* norm_w = args.in[2]; const float* w_in = args.in[3];
    const float* conv_w = args.in[4]; const float* lb_logits = args.in[5]; const float* hg_norm_w = args.in[6]; const float* A_log = args.in[7];
    const float* dt_bias = args.in[8]; const float* gdn_norm_w = args.in[9]; const float* w_out = args.in[10]; const float* final_w = args.in[11];
    unsigned char* ws = args.ws; float* out = args.out;
    bf16* Win_t = (bf16*)(ws + WS_WIN); bf16* Wout_t = (bf16*)(ws + WS_WOUT); bf16* U = (bf16*)(ws + WS_U); bf16* P = (bf16*)(ws + WS_PROJ); bf16* Y = (bf16*)(ws + WS_Y);
    for (int u = tid; u < (LDS_BYTES - MISC_OFF) / 4; u += NT) ((LAS unsigned*)(L + MISC_OFF))[u] = 0u;
    __syncthreads();
    XcdBarrier bar = xcd_barrier_post((unsigned*)(ws + WS_CTL), MISC + 8);
    const int gw = vcu * NWAVES + wave, NGW = G * NWAVES;

    {
        LAS float* scr = (LAS float*)(L + wave * 16384);
        constexpr int I_IN = (D / 64) * (NPAD / 32), I_OUT = (D / 64) * (D / 32);
        for (int it = gw; it < I_IN + I_OUT; it += NGW) {
            if (it < I_IN) { const int kb = it / (NPAD / 32), nb = it % (NPAD / 32);
                const int nblk = (INCOLS + 31) / 32;
                if (nb < nblk) p_transpose_item(w_in, D, INCOLS, Win_t, scr, kb * nblk + nb, lane);
                else { const int c = lane & 7;
#pragma unroll
                    for (int j = 0; j < 4; ++j) { const int n = (lane >> 3) + 8 * j; *(uint4*)(Win_t + (size_t)(nb * 32 + n) * D + kb * 64 + 8 * c) = make_uint4(0u, 0u, 0u, 0u); } }
            } else p_transpose_item(w_out, D, D, Wout_t, scr, it - I_IN, lane);
        }
        p_norm_in(x, meta, norm_w, U, gw, NGW, lane);
    }
    xcd_barrier(bar);
    { pg8::Gemm g{U, Win_t, MROWS, NPAD, D, 0}; pg8::StaticOrder S; S.init(MROWS, NPAD, G, bx); pg8::EpiBf16 E{P, NPAD, 0};
      if (!SK_G1) pg8::gemm_phase<pg8::EpiBf16, pg8::StaticOrder, true, true>(L, g, S, E); }
    xcd_barrier(bar);
    {
        unsigned char* hrecs = (unsigned char*)out; unsigned char* grecs = ws + WS_GREC;
        LAS unsigned char* wl = L + wave * 18432;
        for (int u = gw; u < 8200; u += NGW) {
            int ur = u & 4095; const bool gdn = (u < 4096) || (u >= 8192 && u < 8196);
            int b, h, c;
            if (u < 8192) { b = ur >> 8; h = (ur >> 6) & 3; c = 1 + (ur & 63); } else { b = 0; h = u & 3; c = 0; }
            if (u < 8192) {
                if (gdn) prep_gdn<false>(wl, b, h, c, P, conv_w, A_log, dt_bias, grecs + rec_index(b, h, c) * GREC_BYTES, lane);
                else prep_hgrn2<false>(wl, b, h, c, P, lb_logits, hrecs + rec_index(b, h, c) * HREC_BYTES, lane);
            } else {
                if (gdn) prep_gdn<true>(wl, b, h, c, P, conv_w, A_log, dt_bias, grecs + rec_index(b, h, c) * GREC_BYTES, lane);
                else prep_hgrn2<true>(wl, b, h, c, P, lb_logits, hrecs + rec_index(b, h, c) * HREC_BYTES, lane);
            }
        }
    }
    xcd_barrier(bar);
    for (int unit = bx; unit < 128; unit += G) {
        if (unit < 64) { if (!SK_SH) seq_hgrn2(L, unit >> 2, unit & 3, P, (const unsigned char*)out, hg_norm_w, Y); }
        else if (!SK_SG) seq_gdn(L, (unit - 64) >> 2, unit & 3, P, ws + WS_GREC, gdn_norm_w, Y);
    }
    xcd_barrier(bar);
    { pg8::Gemm g{Y, Wout_t, MREAL, D, D, 0}; pg8::StaticOrder S; S.init(MREAL, D, G, bx); pg8::EpiResF32 E{x, out, D, 0};
      pg8::gemm_phase<pg8::EpiResF32, pg8::StaticOrder, true, true>(L, g, S, E); }
    xcd_barrier(bar);
    p_norm_out(out, final_w, gw, NGW, lane);
}

extern "C" void kernel_launch(void* const* d_in, const int* in_sizes, int n_in, void* d_out, int out_size, void* d_ws, size_t ws_size, hipStream_t stream) {
    static int grid = 0;
    if (grid == 0) {
        if (n_in != 12 || in_sizes[0] != MREAL * D || out_size != MREAL * D || ws_size < WS_END) { fprintf(stderr, "kernel_launch: unexpected shapes n_in %d in0 %d out %d ws %zu\n", n_in, n_in > 0 ? in_sizes[0] : -1, out_size, ws_size); grid = -1; return; }
        int dev = 0, cus = 0, per_cu = 0;
        if (hipGetDevice(&dev) != hipSuccess || hipDeviceGetAttribute(&cus, hipDeviceAttributeMultiprocessorCount, dev) != hipSuccess) { grid = -1; return; }
        if (hipFuncSetAttribute((const void*)fwd_megakernel, hipFuncAttributeMaxDynamicSharedMemorySize, LDS_BYTES) != hipSuccess) { fprintf(stderr, "kernel_launch: hipFuncSetAttribute failed\n"); grid = -1; return; }
        if (hipOccupancyMaxActiveBlocksPerMultiprocessor(&per_cu, (const void*)fwd_megakernel, NT, LDS_BYTES) != hipSuccess || per_cu < 1) { fprintf(stderr, "kernel_launch: occupancy query says %d blocks/CU\n", per_cu); }
        (void)hipGetLastError();
        grid = cus;
    }
    if (grid < 0) return;
    if (hipMemsetAsync((char*)d_ws + WS_CTL, 0, CTL_ZERO_BYTES, stream) != hipSuccess) return;
    Args a{};
    for (int i = 0; i < 12; ++i) a.in[i] = (const float*)d_in[i];
    a.out = (float*)d_out; a.ws = (unsigned char*)d_ws;
    hipLaunchKernelGGL(fwd_megakernel, dim3(grid), dim3(NT), LDS_BYTES, stream, a);
}
```
